# Optimizing an MI355X kernel written in HIP

```python
import jax, jax.numpy as jnp
from jax import lax
import numpy as np

D_MODEL = 1024
BATCH = 32
SEQ = 2048
DEPTH = 1

N_META = 16
D_CONV = D_MODEL
CONV_WIDTH = 3
GLA_HEADS = 4
DK = D_MODEL // 2
DV = D_MODEL
HEAD_K = DK // GLA_HEADS
HEAD_V = DV // GLA_HEADS
GATE_RANK = 16
GATE_NORMALIZER = 16.0
CHUNK = 64
EPS = 1e-6
IN_SPLITS = (D_CONV, D_CONV, D_CONV, D_CONV, DK, DK, DV, DV, GATE_RANK, GATE_RANK, D_MODEL, D_MODEL)
N_IN = sum(IN_SPLITS)

kernel_name = "hybrid_gated_shortconv_bigla_block"


def rms_norm(x, g):
    xf = x.astype(jnp.float32)
    y = xf * lax.rsqrt(jnp.mean(xf * xf, axis=-1, keepdims=True) + EPS)
    return (y * g.astype(jnp.float32)).astype(x.dtype)


def short_conv_centred(u, w):
    half = CONV_WIDTH // 2
    L = u.shape[1]
    up = jnp.pad(u, ((0, 0), (half, half), (0, 0)))
    return sum(up[:, i:i + L] * w[i] for i in range(CONV_WIDTH))


def to_chunks(t, pad_front, pad_back, n_heads, head_dim):
    t = jnp.pad(t, ((0, 0), (pad_front, pad_back), (0, 0)))
    bn, lp, _ = t.shape
    t = t.reshape(bn, lp // CHUNK, CHUNK, n_heads, head_dim)
    return t.transpose(0, 3, 1, 2, 4)


def gla_chunked(q, k, v, g, strict):
    bn, nh, _, c, dk = q.shape
    dv = v.shape[-1]
    b = jnp.cumsum(g.astype(jnp.float32), axis=3)
    q_in = q * jnp.exp(b)
    k_in = k * jnp.exp(-b)
    scores = jnp.einsum('bhncd,bhnjd->bhncj', q_in, k_in)
    mask = jnp.tril(jnp.ones((c, c), dtype=bool), k=-1 if strict else 0)
    scores = jnp.where(mask, scores, 0.0)
    o_intra = jnp.einsum('bhncj,bhnje->bhnce', scores, v)
    b_last = b[..., -1:, :]
    k_dec = k * jnp.exp(b_last - b)
    decay = jnp.exp(b_last[..., 0, :])

    def step(state, xs):
        q_n, k_n, v_n, d_n = xs
        o_n = jnp.einsum('bhcd,bhde->bhce', q_n, state)
        state = state * d_n[..., None] + jnp.einsum('bhcd,bhce->bhde', k_n, v_n)
        return state, o_n

    xs = tuple(jnp.moveaxis(t, 2, 0) for t in (q_in, k_dec, v, decay))
    s0 = jnp.zeros((bn, nh, dk, dv), jnp.float32)
    _, o_inter = lax.scan(step, s0, xs)
    return o_intra + jnp.moveaxis(o_inter, 0, 2)


def hybrid_layer(h, g_pre, w_in, conv_w, w_gate_f, b_gate_f, w_gate_b, b_gate_b,
                 gla_g, w_out_c, w_out_g, w_out, g_post):
    bn, L, _ = h.shape
    pad_front = (-N_META) % CHUNK
    pad_back = (-(L - N_META)) % CHUNK
    u = rms_norm(h, g_pre)
    proj = jnp.einsum('bld,dn->bln', u, w_in)
    split_idx = np.cumsum(IN_SPLITS)[:-1].tolist()
    (c_b, c_c, c_x, c_z, q, k, v, r, lr_f, lr_b, m_a, m_b) = jnp.split(proj, split_idx, axis=-1)

    y_conv = c_b * short_conv_centred(c_c * c_x, conv_w) * jax.nn.silu(c_z)
    p_conv = jnp.einsum('blc,cd->bld', y_conv, w_out_c)

    g_f = jax.nn.log_sigmoid((lr_f @ w_gate_f + b_gate_f).astype(jnp.float32)) / GATE_NORMALIZER
    g_b = jax.nn.log_sigmoid((lr_b @ w_gate_b + b_gate_b).astype(jnp.float32)) / GATE_NORMALIZER
    qc = to_chunks(q * (HEAD_K ** -0.5), pad_front, pad_back, GLA_HEADS, HEAD_K)
    kc = to_chunks(k, pad_front, pad_back, GLA_HEADS, HEAD_K)
    vc = to_chunks(v, pad_front, pad_back, GLA_HEADS, HEAD_V)
    gfc = to_chunks(g_f, pad_front, pad_back, GLA_HEADS, HEAD_K)
    gbc = to_chunks(g_b, pad_front, pad_back, GLA_HEADS, HEAD_K)
    rev = lambda t: jnp.flip(t, axis=(2, 3))
    o_f = gla_chunked(qc, kc, vc, gfc, strict=False)
    o_b = rev(gla_chunked(rev(qc), rev(kc), rev(vc), rev(gbc), strict=True))
    o = (o_f + o_b).transpose(0, 2, 3, 1, 4).reshape(bn, -1, GLA_HEADS, HEAD_V)
    o = o[:, pad_front:pad_front + L]
    o = rms_norm(o, gla_g).reshape(bn, L, DV).astype(h.dtype)
    y_gla = o * jax.nn.silu(r)
    p_gla = jnp.einsum('blc,cd->bld', y_gla, w_out_g)

    merged = jax.nn.sigmoid(m_a) * p_conv + jax.nn.sigmoid(m_b) * p_gla
    out = jnp.einsum('bld,de->ble', merged, w_out)
    return h + rms_norm(out, g_post)


def setup_inputs(seed: int = 0) -> dict:
    key = jax.random.key(seed)
    ks = jax.random.split(key, 16)
    nrm = lambda k, shape, scale: jax.random.normal(k, shape, jnp.float32) * scale
    return {
        "x": nrm(ks[0], (BATCH, SEQ, D_MODEL), 1.0),
        "meta_tokens": nrm(ks[1], (N_META, D_MODEL), 1.0),
        "norm_pre": 1.0 + nrm(ks[2], (DEPTH, D_MODEL), 0.05),
        "w_in": nrm(ks[3], (DEPTH, D_MODEL, N_IN), D_MODEL ** -0.5),
        "conv_w": nrm(ks[4], (DEPTH, CONV_WIDTH, D_CONV), CONV_WIDTH ** -0.5),
        "w_gate_fwd": nrm(ks[5], (DEPTH, GATE_RANK, DK), GATE_RANK ** -0.5),
        "b_gate_fwd": nrm(ks[6], (DEPTH, DK), 0.1),
        "w_gate_bwd": nrm(ks[7], (DEPTH, GATE_RANK, DK), GATE_RANK ** -0.5),
        "b_gate_bwd": nrm(ks[8], (DEPTH, DK), 0.1),
        "gla_norm": 1.0 + nrm(ks[9], (DEPTH, HEAD_V), 0.05),
        "w_out_conv": nrm(ks[10], (DEPTH, D_CONV, D_MODEL), D_CONV ** -0.5),
        "w_out_gla": nrm(ks[11], (DEPTH, DV, D_MODEL), DV ** -0.5),
        "w_merge_out": nrm(ks[12], (DEPTH, D_MODEL, D_MODEL), D_MODEL ** -0.5),
        "norm_post": 1.0 + nrm(ks[13], (DEPTH, D_MODEL), 0.05),
    }


def reference(x, meta_tokens, norm_pre, w_in, conv_w, w_gate_fwd, b_gate_fwd, w_gate_bwd,
              b_gate_bwd, gla_norm, w_out_conv, w_out_gla, w_merge_out, norm_post):
    bn = x.shape[0]
    meta = jnp.broadcast_to(meta_tokens[None].astype(x.dtype), (bn, N_META, D_MODEL))
    h = jnp.concatenate([meta, x], axis=1)
    for l in range(DEPTH):
        h = hybrid_layer(h, norm_pre[l], w_in[l], conv_w[l], w_gate_fwd[l], b_gate_fwd[l],
                         w_gate_bwd[l], b_gate_bwd[l], gla_norm[l], w_out_conv[l],
                         w_out_gla[l], w_merge_out[l], norm_post[l])
    return h[:, N_META:]
```

```cpp
#include <hip/hip_runtime.h>
#include <hip/hip_cooperative_groups.h>
#include <cstdio>
#include <cstdint>
namespace cg = cooperative_groups;

#ifndef ONE_LAUNCH
#define ONE_LAUNCH 0
#endif

#define LAS __attribute__((address_space(3)))
typedef unsigned short bf16_t;
typedef short bf16x8 __attribute__((ext_vector_type(8)));
typedef short s16x4 __attribute__((ext_vector_type(4)));
typedef float f32x4 __attribute__((ext_vector_type(4)));
typedef float f32x2 __attribute__((ext_vector_type(2)));
typedef float f32x16 __attribute__((ext_vector_type(16)));
typedef unsigned u32x4 __attribute__((ext_vector_type(4)));
typedef unsigned u32x2 __attribute__((ext_vector_type(2)));
typedef __bf16 bf2_t __attribute__((ext_vector_type(2)));

__device__ __forceinline__ unsigned pk2(float lo, float hi) { f32x2 v = {lo, hi}; bf2_t b = __builtin_convertvector(v, bf2_t); return __builtin_bit_cast(unsigned, b); }
__device__ __forceinline__ float bflo(unsigned w) { return __builtin_bit_cast(float, w << 16); }
__device__ __forceinline__ float bfhi(unsigned w) { return __builtin_bit_cast(float, w & 0xffff0000u); }
__device__ __forceinline__ float sigm(float x) { return __builtin_amdgcn_rcpf(1.f + __expf(-x)); }
#define LDS_WAIT() asm volatile("s_waitcnt lgkmcnt(0)" ::: "memory")
#define LBAR() do { asm volatile("s_waitcnt lgkmcnt(0)" ::: "memory"); __builtin_amdgcn_s_barrier(); asm volatile("" ::: "memory"); } while (0)

typedef __amdgpu_buffer_rsrc_t rsrc_t;
typedef unsigned v4u_t __attribute__((__vector_size__(16)));
__device__ __forceinline__ rsrc_t mk_rsrc(const void* p, unsigned bytes) { return __builtin_amdgcn_make_buffer_rsrc((void*)p, (short)0, (int)bytes, 0x00020000); }
__device__ __forceinline__ u32x4 bld128(rsrc_t r, unsigned voff, unsigned soff) { return __builtin_bit_cast(u32x4, __builtin_amdgcn_raw_buffer_load_b128(r, (int)voff, (int)soff, 0)); }
__device__ __forceinline__ void bst128(u32x4 v, rsrc_t r, unsigned voff, unsigned soff) { __builtin_amdgcn_raw_buffer_store_b128(__builtin_bit_cast(v4u_t, v), r, (int)voff, (int)soff, 0); }

constexpr int NB = 32, T = 2048, D = 1024, M = NB * T;
constexpr int NIN = 9248, NSLOT = 9472;
constexpr int NH = 4, DK = 128, DV = 256, CH = 64;
constexpr float EPS = 1e-6f;
constexpr int O_CB = 0, O_CC = 1024, O_CX = 2048, O_CZ = 3072, O_Q = 4096, O_K = 4608, O_V = 5120, O_R = 6144, O_LRF = 7168, O_LRB = 7184, O_MA = 7200, O_MB = 8224;

constexpr size_t MiB = 1u << 20;
constexpr size_t WS_WIN = 1 * MiB, WS_WMG = 20 * MiB, WS_WOUT = 24 * MiB, WS_META = 26 * MiB, WS_LR = 27 * MiB, WS_STATS = 35 * MiB;
constexpr size_t WS_P = 64 * MiB, WS_A2 = 192 * MiB, WS_V = 448 * MiB, WS_SA = 576 * MiB, WS_SB = 704 * MiB, WS_OB = 832 * MiB, WS_END = 960 * MiB;
constexpr size_t WS_MERGED = WS_P;
constexpr size_t META_K = 0, META_V = 65536, META_LR = 65536 + 131072, META_CC = META_LR + 8192, META_CX = META_CC + 4096;
constexpr size_t DO_U = 0, DO_OF = 0, DO_Q = 128 * MiB, DO_K = 192 * MiB;

namespace pg8 {
constexpr int BM = 256, BK = 64, HALF = 128, HTB = HALF * BK * 2, STAGE_BYTES = 8 * HTB, NXCD = 8, WGM = 8;
__host__ __device__ __forceinline__ int lds_byte(int r, int c) { const int st = (r >> 4) * 2 + (c >> 5), rr = r & 15, cc = c & 31, ob = rr * 64 + cc * 2; return st * 1024 + (ob ^ (((ob >> 9) & 1) << 5)); }
__host__ __device__ __forceinline__ void stage_rc(int b, int& R, int& C) { const int st = b / 1024, sb = b % 1024, swz = sb ^ (((sb >> 9) & 1) << 5); R = (st >> 1) * 16 + swz / 64; C = (st & 1) * 32 + (swz % 64) / 2; }
struct Unit { int pm, pn; };
struct Gemm { const bf16_t* A; const bf16_t* Bt; int M, N, K; };
struct StaticOrder {
    int nM, nN, nwg, G, c;
    __host__ __device__ void init(int M_, int N_, int G_, int c_) { nM = M_ / BM; nN = N_ / BM; nwg = nM * nN; G = G_; c = c_; }
    __host__ __device__ bool next(int i, Unit& u) const {
        const long L = (long)i * G + c; if (L >= nwg) return false;
        int wgid = (int)L; { const int q = nwg / NXCD, r = nwg % NXCD, xcd = wgid % NXCD, off = wgid / NXCD; wgid = (xcd < r ? xcd * (q + 1) : r * (q + 1) + (xcd - r) * q) + off; }
        const int nig = WGM * nN, gid = wgid / nig, fm = gid * WGM, gsz = (nM - fm) < WGM ? (nM - fm) : WGM;
        u.pm = fm + ((wgid % nig) % gsz); u.pn = (wgid % nig) / gsz; return true;
    }
};

struct EpiProj {
    static constexpr bool AFTER_DRAIN = false, MID = false;
    bf16_t *P, *A2, *Q, *K, *V, *SA, *SB; float* LR;
    __device__ __forceinline__ void mid(f32x4 (&)[2][2][4][2], const Unit&, int, int, int, int) const {}
    __device__ __forceinline__ void operator()(const f32x4 (&acc)[2][2][4][2], const Unit& u, int wr, int wc, int fr, int fq) const {
        const int row0 = u.pm * BM + wr * 64 + fr; const int pn = u.pn;
        if (pn < 16) {
            const int ch0 = pn * 64 + wc * 16 + fq * 4;
#pragma unroll
            for (int ai = 0; ai < 2; ++ai)
#pragma unroll
                for (int m = 0; m < 4; ++m) {
                    const size_t row = (size_t)(row0 + ai * HALF + m * 16);
                    const f32x4 cb = acc[ai][0][m][0], cc = acc[ai][0][m][1], cx = acc[ai][1][m][0], cz = acc[ai][1][m][1];
                    f32x4 p = cc * cx, g;
#pragma unroll
                    for (int e = 0; e < 4; ++e) g[e] = cb[e] * cz[e] * sigm(cz[e]);
                    u32x2 pw, gw; pw.x = pk2(p[0], p[1]); pw.y = pk2(p[2], p[3]); gw.x = pk2(g[0], g[1]); gw.y = pk2(g[2], g[3]);
                    *(u32x2*)(P + row * D + ch0) = pw; *(u32x2*)(A2 + row * (2 * D) + ch0) = gw;
                }
        } else if (pn < 36) {
            bf16_t* base; int ld, colt; float c0 = 0.f, c1 = 1.f, d0 = 1.f, d1 = 0.f;
            if (pn < 18)      { base = Q; ld = 512; colt = (pn - 16) * 256; c1 = 0.08838834764831845f; }
            else if (pn < 20) { base = K; ld = 512; colt = (pn - 18) * 256; }
            else if (pn < 24) { base = V; ld = D; colt = (pn - 20) * 256; }
            else if (pn < 28) { base = A2 + D; ld = 2 * D; colt = (pn - 24) * 256; d0 = 0.f; d1 = 1.f; }
            else if (pn < 32) { base = SA; ld = D; colt = (pn - 28) * 256; c0 = 1.f; c1 = 0.f; d0 = 0.f; d1 = 1.f; }
            else              { base = SB; ld = D; colt = (pn - 32) * 256; c0 = 1.f; c1 = 0.f; d0 = 0.f; d1 = 1.f; }
            const int col0 = colt + wc * 32 + fq * 8;
#pragma unroll
            for (int ai = 0; ai < 2; ++ai)
#pragma unroll
                for (int m = 0; m < 4; ++m) {
                    bf16_t* rowp = base + (size_t)(row0 + ai * HALF + m * 16) * ld + col0;
#pragma unroll
                    for (int bj = 0; bj < 2; ++bj) {
                        float o[8];
#pragma unroll
                        for (int n = 0; n < 2; ++n)
#pragma unroll
                            for (int e = 0; e < 4; ++e) { const float x = acc[ai][bj][m][n][e]; o[4 * n + e] = (c0 + c1 * x) * (d0 + d1 * sigm(x)); }
                        u32x4 w; w.x = pk2(o[0], o[1]); w.y = pk2(o[2], o[3]); w.z = pk2(o[4], o[5]); w.w = pk2(o[6], o[7]);
                        *(u32x4*)(rowp + bj * HALF) = w;
                    }
                }
        } else {
            if (wc == 0) {
#pragma unroll
                for (int ai = 0; ai < 2; ++ai)
#pragma unroll
                    for (int m = 0; m < 4; ++m) {
                        float* rowp = LR + (size_t)(row0 + ai * HALF + m * 16) * 32 + 4 * fq;
                        *(f32x4*)(rowp) = acc[ai][0][m][0]; *(f32x4*)(rowp + 16) = acc[ai][0][m][1];
                    }
            }
        }
    }
};
struct EpiMerge {
    static constexpr bool AFTER_DRAIN = false, MID = true;
    const bf16_t *SA, *SB; bf16_t* O;
    __device__ __forceinline__ void mid(f32x4 (&acc)[2][2][4][2], const Unit& u, int wr, int wc, int fr, int fq) const {
        const rsrc_t ra = mk_rsrc(SA, (unsigned)((size_t)M * D * 2)), rb = mk_rsrc(SB, (unsigned)((size_t)M * D * 2));
        const unsigned voff = (unsigned)((wr * 64 + fr) * D + wc * 32 + fq * 8) * 2u;
        const unsigned uoff = (unsigned)(u.pm * BM * D + u.pn * BM) * 2u;
#pragma unroll
        for (int ai = 0; ai < 2; ++ai)
#pragma unroll
            for (int m = 0; m < 4; ++m)
#pragma unroll
                for (int bj = 0; bj < 2; ++bj) {
                    const unsigned so = uoff + (unsigned)((ai * HALF + m * 16) * D + bj * HALF) * 2u;
                    const u32x4 a = bld128(ra, voff, so), b = bld128(rb, voff, so);
                    f32x4 r0, r1;
                    r0[0] = bflo(a.x) * __builtin_amdgcn_rcpf(bflo(b.x)); r0[1] = bfhi(a.x) * __builtin_amdgcn_rcpf(bfhi(b.x));
                    r0[2] = bflo(a.y) * __builtin_amdgcn_rcpf(bflo(b.y)); r0[3] = bfhi(a.y) * __builtin_amdgcn_rcpf(bfhi(b.y));
                    r1[0] = bflo(a.z) * __builtin_amdgcn_rcpf(bflo(b.z)); r1[1] = bfhi(a.z) * __builtin_amdgcn_rcpf(bfhi(b.z));
                    r1[2] = bflo(a.w) * __builtin_amdgcn_rcpf(bflo(b.w)); r1[3] = bfhi(a.w) * __builtin_amdgcn_rcpf(bfhi(b.w));
                    acc[ai][bj][m][0] *= r0; acc[ai][bj][m][1] *= r1;
                }
    }
    __device__ __forceinline__ void operator()(const f32x4 (&acc)[2][2][4][2], const Unit& u, int wr, int wc, int fr, int fq) const {
        const rsrc_t rb = mk_rsrc(SB, (unsigned)((size_t)M * D * 2)), ro = mk_rsrc(O, (unsigned)((size_t)M * D * 2));
        const unsigned voff = (unsigned)((wr * 64 + fr) * D + wc * 32 + fq * 8) * 2u;
        const unsigned uoff = (unsigned)(u.pm * BM * D + u.pn * BM) * 2u;
#pragma unroll
        for (int ai = 0; ai < 2; ++ai)
#pragma unroll
            for (int m = 0; m < 4; ++m)
#pragma unroll
                for (int bj = 0; bj < 2; ++bj) {
                    const unsigned so = uoff + (unsigned)((ai * HALF + m * 16) * D + bj * HALF) * 2u;
                    const u32x4 b = bld128(rb, voff, so);
                    const f32x4 v0 = acc[ai][bj][m][0], v1 = acc[ai][bj][m][1];
                    u32x4 w;
                    w.x = pk2(v0[0] * bflo(b.x), v0[1] * bfhi(b.x)); w.y = pk2(v0[2] * bflo(b.y), v0[3] * bfhi(b.y));
                    w.z = pk2(v1[0] * bflo(b.z), v1[1] * bfhi(b.z)); w.w = pk2(v1[2] * bflo(b.w), v1[3] * bfhi(b.w));
                    bst128(w, ro, voff, so);
                }
    }
};
struct EpiOut {
    static constexpr bool AFTER_DRAIN = false, MID = false;
    float* C; float* stats;
    __device__ __forceinline__ void mid(f32x4 (&)[2][2][4][2], const Unit&, int, int, int, int) const {}
    __device__ __forceinline__ void operator()(const f32x4 (&acc)[2][2][4][2], const Unit& u, int wr, int wc, int fr, int fq) const {
        const int row0 = u.pm * BM + wr * 64 + fr, col0 = u.pn * BM + wc * 32 + 4 * fq;
#pragma unroll
        for (int ai = 0; ai < 2; ++ai)
#pragma unroll
            for (int m = 0; m < 4; ++m) {
                const size_t row = (size_t)(row0 + ai * HALF + m * 16);
                float* rowp = C + row * D + col0; float s = 0.f;
#pragma unroll
                for (int bj = 0; bj < 2; ++bj)
#pragma unroll
                    for (int n = 0; n < 2; ++n) { const f32x4 v = acc[ai][bj][m][n]; *(f32x4*)(rowp + bj * HALF + n * 16) = v; s += (v[0] * v[0] + v[1] * v[1]) + (v[2] * v[2] + v[3] * v[3]); }
                s += __shfl_xor(s, 16); s += __shfl_xor(s, 32);
                if (fq == 0) stats[row * 16 + u.pn * 4 + wc] = s;
            }
    }
};

template <class Epi, class Sched>
__device__ __forceinline__ void gemm_phase(LAS unsigned char* lds, const Gemm g, const Sched& S, const Epi& E) {
    const int tid = threadIdx.x, wid = __builtin_amdgcn_readfirstlane(tid >> 6), lane = tid & 63, wr = wid >> 2, wc = wid & 3, fr = lane & 15, fq = lane >> 4;
    const int K = g.K, nt = K / BK;
    unsigned voffA[2];
#pragma unroll
    for (int i = 0; i < 2; ++i) { int R, C; stage_rc(tid * 16 + i * 8192, R, C); voffA[i] = (unsigned)(R * K + C) * 2u; }
    const size_t kstep = (size_t)(BK * 2);
    const size_t hstep = (size_t)HALF * K * 2;
    const size_t tstep = 2 * hstep;
    const unsigned ldsw = (unsigned)wid * 1024u;
    const int aoff = lds_byte(wr * 64 + fr, fq * 8), boff = lds_byte(wc * 32 + fr, fq * 8);
#define PG8_SA(b, h) (((b) * 2 + (h)) * HTB)
#define PG8_SB(b, h) ((4 + (b) * 2 + (h)) * HTB)
#define PG8_STAGE(bufoff, gbase) do { _Pragma("unroll") for (int _i = 0; _i < 2; ++_i) \
        __builtin_amdgcn_global_load_lds((const unsigned*)((const char*)(gbase) + voffA[_i]), (LAS unsigned*)(lds + (bufoff) + ldsw + _i * 8192), 16, 0, 0); } while (0)
#define PG8_LDA(dst, b, h) do { _Pragma("unroll") for (int m = 0; m < 4; ++m) _Pragma("unroll") for (int k = 0; k < 2; ++k) dst[m][k] = *(const LAS bf16x8*)(lds + PG8_SA(b, h) + aoff + m * 2048 + k * 1024); } while (0)
#define PG8_LDB(dst, b, h) do { _Pragma("unroll") for (int n = 0; n < 2; ++n) _Pragma("unroll") for (int k = 0; k < 2; ++k) dst[n][k] = *(const LAS bf16x8*)(lds + PG8_SB(b, h) + boff + n * 2048 + k * 1024); } while (0)
#define PG8_MMA(ai, bj, At, Bt) do { __builtin_amdgcn_s_setprio(1); _Pragma("unroll") for (int m = 0; m < 4; ++m) _Pragma("unroll") for (int n = 0; n < 2; ++n) _Pragma("unroll") for (int k = 0; k < 2; ++k) \
        acc[ai][bj][m][n] = __builtin_amdgcn_mfma_f32_16x16x32_bf16(Bt[n][k], At[m][k], acc[ai][bj][m][n], 0, 0, 0); __builtin_amdgcn_s_setprio(0); } while (0)
#define PG8_WAIT_V(n) asm volatile("s_waitcnt vmcnt(" #n ")" ::: "memory")
#define PG8_WAIT_L(n) asm volatile("s_waitcnt lgkmcnt(" #n ")" ::: "memory")
#define PG8_BAR __builtin_amdgcn_s_barrier()
#define PG8_SCHED __builtin_amdgcn_sched_barrier(0)
    Unit cur, nxt; int ui = 0;
    if (!S.next(0, cur)) return;
    f32x4 acc[2][2][4][2];
#pragma unroll
    for (int a = 0; a < 2; ++a)
#pragma unroll
        for (int b = 0; b < 2; ++b)
#pragma unroll
            for (int m = 0; m < 4; ++m)
#pragma unroll
                for (int n = 0; n < 2; ++n) acc[a][b][m][n] = (f32x4){0.f, 0.f, 0.f, 0.f};
    bf16x8 At[4][2], B0[2][2], B1[2][2];
    const char* cA = (const char*)g.A + (size_t)cur.pm * tstep; const char* cB = (const char*)g.Bt + (size_t)cur.pn * tstep;
    PG8_STAGE(PG8_SB(0, 0), cB); PG8_STAGE(PG8_SB(0, 1), cB + hstep); PG8_STAGE(PG8_SA(0, 0), cA); PG8_STAGE(PG8_SA(0, 1), cA + hstep);
    if (wr == 1) PG8_BAR;
    PG8_WAIT_V(2); PG8_BAR;
    PG8_STAGE(PG8_SB(1, 0), cB + kstep); PG8_STAGE(PG8_SA(1, 0), cA + kstep); PG8_STAGE(PG8_SB(1, 1), cB + hstep + kstep);
    PG8_WAIT_V(6); PG8_BAR;
    for (;;) {
        const bool has_next = S.next(ui + 1, nxt);
        const char* nA = has_next ? (const char*)g.A + (size_t)nxt.pm * tstep : cA; const char* nB = has_next ? (const char*)g.Bt + (size_t)nxt.pn * tstep : cB;
        for (int part = 0; part < (Epi::MID ? 2 : 1); ++part) {
        const int t_lo = part ? (nt >> 1) : 0, t_hi = (Epi::MID && part == 0) ? (nt >> 1) : nt;
        if constexpr (Epi::MID) { if (part == 1) E.mid(acc, cur, wr, wc, fr, fq); }
        for (int t = t_lo; t < t_hi; t += 2) {
            const bool last = (t == nt - 2);
            const char* a1 = cA + (size_t)(t + 1) * kstep;
            const char* a2 = last ? nA : cA + (size_t)(t + 2) * kstep; const char* b2 = last ? nB : cB + (size_t)(t + 2) * kstep;
            const char* a3 = a2 + kstep; const char* b3 = b2 + kstep;
            PG8_LDB(B0, 0, 0); PG8_LDB(B1, 0, 1); PG8_SCHED; PG8_LDA(At, 0, 0); PG8_STAGE(PG8_SA(1, 1), a1 + hstep);
            PG8_WAIT_V(8); PG8_WAIT_L(0); PG8_BAR; PG8_MMA(0, 0, At, B0); PG8_MMA(0, 1, At, B1); PG8_BAR; PG8_SCHED;
            PG8_LDA(At, 0, 1); PG8_STAGE(PG8_SB(0, 0), b2); PG8_STAGE(PG8_SB(0, 1), b2 + hstep); PG8_STAGE(PG8_SA(0, 0), a2);
            PG8_WAIT_V(8); PG8_WAIT_L(0); PG8_BAR; PG8_MMA(1, 0, At, B0); PG8_MMA(1, 1, At, B1); PG8_BAR; PG8_SCHED;
            PG8_LDB(B0, 1, 0); PG8_LDB(B1, 1, 1); PG8_SCHED; PG8_LDA(At, 1, 0); PG8_STAGE(PG8_SA(0, 1), a2 + hstep);
            PG8_WAIT_V(8); PG8_WAIT_L(0); PG8_BAR; PG8_MMA(0, 0, At, B0); PG8_MMA(0, 1, At, B1); PG8_BAR; PG8_SCHED;
            PG8_LDA(At, 1, 1); PG8_STAGE(PG8_SB(1, 0), b3); PG8_STAGE(PG8_SB(1, 1), b3 + hstep); PG8_STAGE(PG8_SA(1, 0), a3);
            PG8_WAIT_V(8); PG8_WAIT_L(0); PG8_BAR; PG8_MMA(1, 0, At, B0); PG8_MMA(1, 1, At, B1); PG8_BAR; PG8_SCHED;
        }
        }
        if (wr == 0) PG8_BAR;
        E(acc, cur, wr, wc, fr, fq);
        if (!has_next) break;
#pragma unroll
        for (int a = 0; a < 2; ++a)
#pragma unroll
            for (int b = 0; b < 2; ++b)
#pragma unroll
                for (int m = 0; m < 4; ++m)
#pragma unroll
                    for (int n = 0; n < 2; ++n) acc[a][b][m][n] = (f32x4){0.f, 0.f, 0.f, 0.f};
        cur = nxt; cA = nA; cB = nB; ++ui;
        if (wr == 1) PG8_BAR;
    }
    PG8_WAIT_V(0);
    PG8_BAR;
#undef PG8_SA
#undef PG8_SB
#undef PG8_STAGE
#undef PG8_LDA
#undef PG8_LDB
#undef PG8_MMA
#undef PG8_WAIT_V
#undef PG8_WAIT_L
#undef PG8_BAR
#undef PG8_SCHED
}
}

namespace gla {
constexpr int QS = 272, SS = 144;
constexpr int L_QI = 0, L_KI = 17408, L_KD = 34816, L_V = 51200, L_ST = 83968, L_E = 93184, L_LR = 125952, L_TOTP = 130048, L_TOT = 132096, L_DEC = 132608, L_END = 133120;
__device__ __forceinline__ int v_st(int k, int c) { const int kk = (k & ~0xC) | ((k & 4) << 1) | ((k & 8) >> 1); return ((kk >> 3) * 4 + (c >> 5)) * 512 + ((kk & 7) * 32 + (c & 31)) * 2; }
__device__ __forceinline__ int v_rd_base(int lane) { return ((lane & 3) << 3) | (((lane >> 2) & 3) << 6) | (((lane >> 4) & 1) << 5) | (((lane >> 5) & 1) << 8); }
__host__ __device__ constexpr int v_rd_off(int d0, int ks, int half) { return d0 * 512 + ks * 4096 + half * 2048; }
__device__ __forceinline__ int crow(int r, int h) { return (r & 3) + 8 * (r >> 2) + 4 * h; }
__device__ __forceinline__ s16x4 tr_read(const LAS unsigned char* p) { return __builtin_bit_cast(s16x4, __builtin_amdgcn_ds_read_tr16_b64_v4i16((LAS s16x4*)p)); }
__device__ __forceinline__ bf16x8 cat8(s16x4 lo, s16x4 hi) { return __builtin_shufflevector(lo, hi, 0, 1, 2, 3, 4, 5, 6, 7); }
#define MFMA32(a, b, c) __builtin_amdgcn_mfma_f32_32x32x16_bf16((a), (b), (c), 0, 0, 0)
#define MFMA16(a, b, c) __builtin_amdgcn_mfma_f32_16x16x32_bf16((a), (b), (c), 0, 0, 0)

struct Tensors {
    const bf16_t *Q, *K, *V; const float* LR;
    const bf16_t *Kmeta, *Vmeta; const float* LRmeta;
    const float *wgf, *bgf, *wgb, *bgb;
    bf16_t *OF, *OB;
};

__device__ __forceinline__ void unit(LAS unsigned char* lds, const Tensors& X, int b, int h, int dir) {
    const int tid = threadIdx.x, lane = tid & 63, wid = __builtin_amdgcn_readfirstlane(tid >> 6), r32 = lane & 31, hi = lane >> 5;
    const int dcol = tid & 127, rg = __builtin_amdgcn_readfirstlane(tid >> 7);
    const float* wg = dir ? X.wgb : X.wgf; const float* bg = dir ? X.bgb : X.bgf;
    float wgr[16];
#pragma unroll
    for (int r = 0; r < 16; ++r) wgr[r] = wg[r * 512 + h * DK + dcol];
    const float bias = bg[h * DK + dcol];
    f32x16 S[4];
#pragma unroll
    for (int i = 0; i < 4; ++i)
#pragma unroll
        for (int r = 0; r < 16; ++r) S[i][r] = 0.f;
    const int nsteps = dir ? 32 : 33;
    u32x4 qreg[2], kreg[2], vreg[4]; f32x2 lrreg;
    const int qj0 = tid >> 4, qo = tid & 15;
    const int vj0 = tid >> 5, vp = tid & 31;
    const int lj = tid >> 3, lc = (tid & 7) * 2;
    bf16_t* Obase = dir ? X.OB : X.OF;
#define GLA_PREFETCH(step_) do { const int s_ = (step_); const bf16_t *qp_, *kp_, *vp_; const float* lp_; \
        if (dir == 0 && s_ == 0) { qp_ = X.Kmeta + h * DK; kp_ = qp_; vp_ = X.Vmeta + h * DV; lp_ = X.LRmeta; } \
        else { const int c_ = dir ? (31 - s_) : (s_ - 1); const size_t rb_ = (size_t)b * T + (size_t)c_ * CH; \
               qp_ = X.Q + rb_ * 512 + h * DK; kp_ = X.K + rb_ * 512 + h * DK; vp_ = X.V + rb_ * D + h * DV; lp_ = X.LR + rb_ * 32 + dir * 16; } \
        _Pragma("unroll") for (int it = 0; it < 2; ++it) { qreg[it] = *(const u32x4*)(qp_ + (unsigned)((qj0 + 32 * it) * 512 + qo * 8)); kreg[it] = *(const u32x4*)(kp_ + (unsigned)((qj0 + 32 * it) * 512 + qo * 8)); } \
        _Pragma("unroll") for (int it = 0; it < 4; ++it) vreg[it] = *(const u32x4*)(vp_ + (unsigned)((vj0 + 16 * it) * D + vp * 8)); \
        lrreg = *(const f32x2*)(lp_ + (unsigned)(lj * 32 + lc)); } while (0)
    GLA_PREFETCH(0);
    LAS unsigned char* const w_v  = lds + L_V + ((vp * 8) >> 7) * 16384 + v_st(vj0, (vp * 8) & 127);
    LAS unsigned char* const w_lr = lds + L_LR + (lj * 16 + lc) * 4;
    const LAS unsigned char* const r_lr = lds + L_LR + rg * 1024;
    LAS unsigned char* const w_totp = lds + L_TOTP + (rg * 128 + dcol) * 4;
    const LAS unsigned char* const r_totp = lds + L_TOTP + dcol * 4;
    LAS unsigned char* const w_e = lds + L_E + (rg * 16 * 128 + dcol) * 4;
    const LAS unsigned char* const r_e = lds + L_E + (qj0 * 128 + qo * 8) * 4;
    const LAS unsigned char* const r_tot = lds + L_TOT + qo * 32;
    LAS unsigned char* const w_qi = lds + L_QI + qj0 * QS + qo * 16;
    LAS unsigned char* const w_kd = lds + L_KD + v_st(qj0, qo * 8);
    const LAS unsigned char* const r_sc = lds + (lane & 15) * QS + (lane >> 4) * 16;
    LAS unsigned char* const w_st = lds + L_ST + (lane & 15) * SS + (lane >> 4) * 8;
    const LAS unsigned char* const r_qi = lds + L_QI + r32 * QS + hi * 8;
    const LAS unsigned char* const r_st = lds + L_ST + r32 * SS + hi * 16;
    const LAS unsigned char* const r_dec = lds + L_DEC + hi * 16;
    const LAS unsigned char* const vbase = lds + L_V + (wid >> 2) * 16384 + (wid & 3) * 512 + v_rd_base(lane);
    const LAS unsigned char* const kdbase = lds + L_KD + v_rd_base(lane);
    for (int step = 0; step < nsteps; ++step) {
#pragma unroll
        for (int it = 0; it < 4; ++it) *(LAS u32x4*)(w_v + it * 4096) = vreg[it];
        *(LAS f32x2*)(w_lr) = lrreg;
        LBAR();
        float e[16]; float run = 0.f;
        {
            float gv[16];
#pragma unroll
            for (int jj = 0; jj < 16; ++jj) {
                const LAS f32x4* lr4 = (const LAS f32x4*)(r_lr + jj * 64);
                float z = bias;
#pragma unroll
                for (int q = 0; q < 4; ++q) { const f32x4 l = lr4[q]; z += l[0] * wgr[4 * q] + l[1] * wgr[4 * q + 1] + l[2] * wgr[4 * q + 2] + l[3] * wgr[4 * q + 3]; }
                gv[jj] = (fminf(z, 0.f) - __logf(1.f + __expf(-fabsf(z)))) * 0.0625f;
            }
            if (dir == 0) {
#pragma unroll
                for (int jj = 0; jj < 16; ++jj) { run += gv[jj]; e[jj] = run; }
            } else {
#pragma unroll
                for (int jj = 15; jj >= 0; --jj) { run += gv[jj]; e[jj] = run; }
            }
        }
        *(LAS float*)(w_totp) = run;
        LBAR();
        {
            const float t0 = *(const LAS float*)(r_totp), t1 = *(const LAS float*)(r_totp + 512), t2 = *(const LAS float*)(r_totp + 1024), t3 = *(const LAS float*)(r_totp + 1536);
            const float total = (t0 + t1) + (t2 + t3);
            float off;
            if (dir == 0) off = rg == 0 ? 0.f : (rg == 1 ? t0 : (rg == 2 ? t0 + t1 : t0 + t1 + t2));
            else          off = rg == 3 ? 0.f : (rg == 2 ? t3 : (rg == 1 ? t3 + t2 : t3 + t2 + t1));
#pragma unroll
            for (int jj = 0; jj < 16; ++jj) *(LAS float*)(w_e + jj * 512) = e[jj] + off;
            if (rg == 0) { *(LAS float*)(lds + L_TOT + dcol * 4) = total; *(LAS float*)(lds + L_DEC + dcol * 4) = __expf(total); }
        }
        LBAR();
#pragma unroll
        for (int it = 0; it < 2; ++it) {
            const f32x4 e0 = *(const LAS f32x4*)(r_e + it * 16384), e1 = *(const LAS f32x4*)(r_e + it * 16384 + 16);
            const f32x4 t0 = *(const LAS f32x4*)(r_tot), t1 = *(const LAS f32x4*)(r_tot + 16);
            float ev[8] = {e0[0], e0[1], e0[2], e0[3], e1[0], e1[1], e1[2], e1[3]}, tv[8] = {t0[0], t0[1], t0[2], t0[3], t1[0], t1[1], t1[2], t1[3]};
            const unsigned qw[4] = {qreg[it].x, qreg[it].y, qreg[it].z, qreg[it].w}, kw[4] = {kreg[it].x, kreg[it].y, kreg[it].z, kreg[it].w};
            unsigned qi[4], ki[4], kd[4];
#pragma unroll
            for (int p = 0; p < 4; ++p) {
                const float q0 = bflo(qw[p]), q1 = bfhi(qw[p]), k0 = bflo(kw[p]), k1 = bfhi(kw[p]);
                const float a0 = ev[2 * p], a1 = ev[2 * p + 1];
                qi[p] = pk2(q0 * __expf(a0), q1 * __expf(a1));
                ki[p] = pk2(k0 * __expf(-a0), k1 * __expf(-a1));
                kd[p] = pk2(k0 * __expf(tv[2 * p] - a0), k1 * __expf(tv[2 * p + 1] - a1));
            }
            *(LAS u32x4*)(w_qi + it * 32 * QS) = (u32x4){qi[0], qi[1], qi[2], qi[3]};
            *(LAS u32x4*)(w_qi + (L_KI - L_QI) + it * 32 * QS) = (u32x4){ki[0], ki[1], ki[2], ki[3]};
            *(LAS u32x4*)(w_kd + it * 8192) = (u32x4){kd[0], kd[1], kd[2], kd[3]};
        }
        if (step + 1 < nsteps) GLA_PREFETCH(step + 1);
        LBAR();
#pragma unroll
        for (int tt = 0; tt < 2; ++tt) {
            const int id = 2 * wid + tt, tj = id >> 2, ti = id & 3;
            const bool need = dir == 0 ? (tj <= ti) : (tj >= ti);
            f32x4 sc = {0.f, 0.f, 0.f, 0.f};
            if (need) {
                const LAS unsigned char* pa = r_sc + L_KI + tj * (16 * QS); const LAS unsigned char* pb = r_sc + L_QI + ti * (16 * QS);
#pragma unroll
                for (int ks = 0; ks < 4; ++ks) sc = MFMA16(*(const LAS bf16x8*)(pa + ks * 64), *(const LAS bf16x8*)(pb + ks * 64), sc);
            }
            const int i = 16 * ti + (lane & 15), j0 = 16 * tj + 4 * (lane >> 4);
#pragma unroll
            for (int r = 0; r < 4; ++r) { const int j = j0 + r; const bool keep = dir == 0 ? (j <= i) : (j > i); if (!keep) sc[r] = 0.f; }
            *(LAS u32x2*)(w_st + ti * (16 * SS) + tj * 32) = (u32x2){pk2(sc[0], sc[1]), pk2(sc[2], sc[3])};
        }
        f32x16 o[2];
#pragma unroll
        for (int r = 0; r < 16; ++r) { o[0][r] = 0.f; o[1][r] = 0.f; }
#pragma unroll
        for (int dt = 0; dt < 4; ++dt)
#pragma unroll
            for (int s = 0; s < 2; ++s) {
                u32x4 bw; bw.x = pk2(S[dt][8 * s + 0], S[dt][8 * s + 1]); bw.y = pk2(S[dt][8 * s + 2], S[dt][8 * s + 3]); bw.z = pk2(S[dt][8 * s + 4], S[dt][8 * s + 5]); bw.w = pk2(S[dt][8 * s + 6], S[dt][8 * s + 7]);
                const bf16x8 bfr = __builtin_bit_cast(bf16x8, bw);
#pragma unroll
                for (int it = 0; it < 2; ++it) {
                    const LAS unsigned char* p = r_qi + it * (32 * QS) + dt * 64 + s * 32;
                    o[it] = MFMA32(cat8(*(const LAS s16x4*)(p), *(const LAS s16x4*)(p + 16)), bfr, o[it]);
                }
            }
        LBAR();
        bf16x8 Bv[4];
#pragma unroll
        for (int ks = 0; ks < 4; ++ks) Bv[ks] = cat8(tr_read(vbase + v_rd_off(0, ks, 0)), tr_read(vbase + v_rd_off(0, ks, 1)));
#pragma unroll
        for (int ks = 0; ks < 4; ++ks)
#pragma unroll
            for (int it = 0; it < 2; ++it) o[it] = MFMA32(*(const LAS bf16x8*)(r_st + it * (32 * SS) + ks * 32), Bv[ks], o[it]);
#pragma unroll
        for (int dt = 0; dt < 4; ++dt)
#pragma unroll
            for (int g4 = 0; g4 < 4; ++g4) {
                const f32x4 dc = *(const LAS f32x4*)(r_dec + dt * 128 + g4 * 32);
#pragma unroll
                for (int x = 0; x < 4; ++x) S[dt][4 * g4 + x] *= dc[x];
            }
#pragma unroll
        for (int dt = 0; dt < 4; ++dt)
#pragma unroll
            for (int ks = 0; ks < 4; ++ks) S[dt] = MFMA32(cat8(tr_read(kdbase + v_rd_off(dt, ks, 0)), tr_read(kdbase + v_rd_off(dt, ks, 1))), Bv[ks], S[dt]);
        if (!(dir == 0 && step == 0)) {
            const int c = dir ? (31 - step) : (step - 1);
            bf16_t* op = Obase + ((size_t)b * T + (size_t)c * CH) * D + h * DV + 32 * wid;
            const unsigned lo_ = (unsigned)(4 * hi * D + r32);
#pragma unroll
            for (int it = 0; it < 2; ++it)
#pragma unroll
                for (int r = 0; r < 16; ++r) op[lo_ + (unsigned)((32 * it + (r & 3) + 8 * (r >> 2)) * D)] = (bf16_t)(pk2(o[it][r], 0.f) & 0xffffu);
        }
        LBAR();
    }
#undef GLA_PREFETCH
}
}

constexpr int NWAVES = 8, LDS_BYTES = 147456;
struct Args { const float* in[14]; float* out; unsigned char* ws; int ph_lo, ph_hi; };
struct Frame {
    LAS unsigned char* lds; int tid, lane, wave, G, vcu;
    const float *x, *meta, *g_pre, *w_in, *conv_w, *wgf, *bgf, *wgb, *bgb, *gn, *w_oc, *w_og, *w_mo, *g_post;
    float* out; unsigned char* ws;
};
__device__ __forceinline__ float wave_sum(float v) {
#pragma unroll
    for (int o = 1; o < 64; o <<= 1) v += __shfl_xor(v, o);
    return v;
}
__device__ __forceinline__ int win_src_col(int r) {
    const int pn = r >> 8, s = r & 255, bj = s >> 7, wc = (s >> 5) & 3, n = (s >> 4) & 1, fq = (s >> 2) & 3, e = s & 3;
    if (pn < 16) return (2 * bj + n) * 1024 + pn * 64 + wc * 16 + fq * 4 + e;
    const int oc = 128 * bj + 32 * wc + 8 * fq + 4 * n + e;
    if (pn < 18) return O_Q + (pn - 16) * 256 + oc;
    if (pn < 20) return O_K + (pn - 18) * 256 + oc;
    if (pn < 24) return O_V + (pn - 20) * 256 + oc;
    if (pn < 28) return O_R + (pn - 24) * 256 + oc;
    if (pn < 32) return O_MA + (pn - 28) * 256 + oc;
    if (pn < 36) return O_MB + (pn - 32) * 256 + oc;
    return s < 32 ? O_LRF + s : -1;
}
__device__ __forceinline__ int perm_col(int r) {
    const int pn = r >> 8, s = r & 255, bj = s >> 7, wc = (s >> 5) & 3, n = (s >> 4) & 1, fq = (s >> 2) & 3, e = s & 3;
    return pn * 256 + 128 * bj + 32 * wc + 8 * fq + 4 * n + e;
}
template <class SrcFn> __device__ __forceinline__ void transpose_item(SrcFn src, bf16_t* Wt, int Kd, int r0, int k0, LAS float* scr, int lane) {
#pragma unroll 8
    for (int i = 0; i < 32; ++i) { const int kk = 2 * i + (lane >> 5); scr[kk * 33 + (lane & 31)] = src(k0 + kk, r0 + (lane & 31)); }
    LDS_WAIT(); asm volatile("" ::: "memory");
    const int c = lane & 7;
#pragma unroll
    for (int j = 0; j < 4; ++j) { const int n = (lane >> 3) + 8 * j; const LAS float* s = scr + (8 * c) * 33 + n;
        u32x4 o; o.x = pk2(s[0 * 33], s[1 * 33]); o.y = pk2(s[2 * 33], s[3 * 33]); o.z = pk2(s[4 * 33], s[5 * 33]); o.w = pk2(s[6 * 33], s[7 * 33]);
        *(u32x4*)(Wt + (size_t)(r0 + n) * Kd + k0 + 8 * c) = o; }
    LDS_WAIT(); asm volatile("" ::: "memory");
}
__device__ __forceinline__ void p0_meta(Frame& F, int blk) {
    LAS float* umT = (LAS float*)F.lds;
    for (int rr = 0; rr < 2; ++rr) {
        const int j = 2 * F.wave + rr; const float* mr = F.meta + (size_t)j * D;
        f32x4 v[4]; float s = 0.f;
#pragma unroll
        for (int q = 0; q < 4; ++q) { v[q] = *(const f32x4*)(mr + 4 * F.lane + 256 * q); s += (v[q][0] * v[q][0] + v[q][1] * v[q][1]) + (v[q][2] * v[q][2] + v[q][3] * v[q][3]); }
        const float rstd = 1.0f / sqrtf(wave_sum(s) * (1.f / D) + EPS);
#pragma unroll
        for (int q = 0; q < 4; ++q)
#pragma unroll
            for (int e = 0; e < 4; ++e) { const int col = 4 * F.lane + 256 * q + e; umT[col * 16 + j] = v[q][e] * rstd * F.g_pre[col]; }
    }
    __syncthreads();
    const int ci = blk * 512 + F.tid;
    if (ci < 3600) {
        const int src = ci < 2048 ? (O_CC + ci) : (ci < 3584 ? (O_K + (ci - 2048)) : (O_LRF + (ci - 3584)));
        float acc[16];
#pragma unroll
        for (int j = 0; j < 16; ++j) acc[j] = 0.f;
        const float* wp = F.w_in + src;
#pragma unroll 4
        for (int k = 0; k < D; ++k) {
            const float w = wp[(size_t)k * NIN];
            const LAS f32x4* u4 = (const LAS f32x4*)(umT + k * 16);
#pragma unroll
            for (int q = 0; q < 4; ++q) { const f32x4 u = u4[q]; acc[4 * q] += w * u[0]; acc[4 * q + 1] += w * u[1]; acc[4 * q + 2] += w * u[2]; acc[4 * q + 3] += w * u[3]; }
        }
        unsigned char* mb = F.ws + WS_META;
        if (ci < 1024) ((float*)(mb + META_CC))[ci] = acc[15];
        else if (ci < 2048) ((float*)(mb + META_CX))[ci - 1024] = acc[15];
        else if (ci < 2560) { bf16_t* kmeta = (bf16_t*)(mb + META_K); const int c = ci - 2048;
            for (int j = 0; j < 48; ++j) kmeta[j * 512 + c] = 0;
#pragma unroll
            for (int j = 0; j < 16; ++j) kmeta[(48 + j) * 512 + c] = (bf16_t)(pk2(acc[j], 0.f) & 0xffffu); }
        else if (ci < 3584) { bf16_t* vmeta = (bf16_t*)(mb + META_V); const int c = ci - 2560;
            for (int j = 0; j < 48; ++j) vmeta[j * 1024 + c] = 0;
#pragma unroll
            for (int j = 0; j < 16; ++j) vmeta[(48 + j) * 1024 + c] = (bf16_t)(pk2(acc[j], 0.f) & 0xffffu); }
        else { float* lrm = (float*)(mb + META_LR); const int c = ci - 3584;
            for (int j = 0; j < 48; ++j) { lrm[j * 32 + c] = 0.f; lrm[j * 32 + 16 + c] = 0.f; }
#pragma unroll
            for (int j = 0; j < 16; ++j) { lrm[(48 + j) * 32 + c] = acc[j]; lrm[(48 + j) * 32 + 16 + c] = 0.f; } }
    }
    __syncthreads();
}
__device__ __forceinline__ void p0_prologue(Frame& F) {
    if (blockIdx.x < 8) p0_meta(F, (int)blockIdx.x);
    LAS float* scr = (LAS float*)(F.lds + F.wave * 16384);
    const int gw = F.vcu * NWAVES + F.wave, NGW = F.G * NWAVES;
    bf16_t* Wt_in = (bf16_t*)(F.ws + WS_WIN); bf16_t* Wt_mg = (bf16_t*)(F.ws + WS_WMG); bf16_t* Wt_out = (bf16_t*)(F.ws + WS_WOUT);
    constexpr int I_IN = (NSLOT / 32) * (D / 64), I_MG = (D / 32) * (2 * D / 64), I_OUT = (D / 32) * (D / 64);
    const float* w_in = F.w_in; const float* w_oc = F.w_oc; const float* w_og = F.w_og; const float* w_mo = F.w_mo;
    for (int it = gw; it < I_IN + I_MG + I_OUT; it += NGW) {
        int r = it;
        if (r < I_IN) { const int rb = r / (D / 64), kb = r % (D / 64);
            transpose_item([=](int k, int row) { const int c = win_src_col(row); return c < 0 ? 0.f : w_in[(size_t)k * NIN + c]; }, Wt_in, D, rb * 32, kb * 64, scr, F.lane); continue; }
        r -= I_IN;
        if (r < I_MG) { const int rb = r / (2 * D / 64), kb = r % (2 * D / 64);
            transpose_item([=](int k, int row) { const int c = perm_col(row); return k < D ? w_oc[(size_t)k * D + c] : w_og[(size_t)(k - D) * D + c]; }, Wt_mg, 2 * D, rb * 32, kb * 64, scr, F.lane); continue; }
        r -= I_MG;
        { const int rb = r / (D / 64), kb = r % (D / 64);
            transpose_item([=](int k, int row) { return w_mo[(size_t)k * D + row]; }, Wt_out, D, rb * 32, kb * 64, scr, F.lane); }
    }
    bf16_t* U = (bf16_t*)((unsigned char*)F.out + DO_U);
    f32x4 gp[4];
#pragma unroll
    for (int q = 0; q < 4; ++q) gp[q] = *(const f32x4*)(F.g_pre + 4 * F.lane + 256 * q);
    for (int m = gw; m < M; m += NGW) {
        const float* xr = F.x + (size_t)m * D + 4 * F.lane;
        f32x4 v[4]; float s = 0.f;
#pragma unroll
        for (int q = 0; q < 4; ++q) { v[q] = *(const f32x4*)(xr + 256 * q); s += (v[q][0] * v[q][0] + v[q][1] * v[q][1]) + (v[q][2] * v[q][2] + v[q][3] * v[q][3]); }
        const float rstd = 1.0f / sqrtf(wave_sum(s) * (1.f / D) + EPS);
        bf16_t* ur = U + (size_t)m * D + 4 * F.lane;
#pragma unroll
        for (int q = 0; q < 4; ++q) { const f32x4 y = v[q] * rstd * gp[q]; *(u32x2*)(ur + 256 * q) = (u32x2){pk2(y[0], y[1]), pk2(y[2], y[3])}; }
    }
}
__device__ __forceinline__ void p3_prep(Frame& F) {
    const int gw = F.vcu * NWAVES + F.wave, NGW = F.G * NWAVES;
    const bf16_t* P = (const bf16_t*)(F.ws + WS_P); bf16_t* A2 = (bf16_t*)(F.ws + WS_A2);
    const bf16_t* OF = (const bf16_t*)((unsigned char*)F.out + DO_OF); const bf16_t* OB = (const bf16_t*)(F.ws + WS_OB);
    const float* cc15 = (const float*)(F.ws + WS_META + META_CC); const float* cx15 = (const float*)(F.ws + WS_META + META_CX);
    for (int t = gw; t < M; t += NGW) {
        const int tl = t & (T - 1);
#pragma unroll
        for (int half = 0; half < 2; ++half) {
            const int c0 = half * 512 + 8 * F.lane;
            const u32x4 gq = *(const u32x4*)(A2 + (size_t)t * (2 * D) + c0);
            const u32x4 p0 = *(const u32x4*)(P + (size_t)t * D + c0);
            float pm[8], pp[8];
            if (tl != 0) { const u32x4 w = *(const u32x4*)(P + (size_t)(t - 1) * D + c0); pm[0] = bflo(w.x); pm[1] = bfhi(w.x); pm[2] = bflo(w.y); pm[3] = bfhi(w.y); pm[4] = bflo(w.z); pm[5] = bfhi(w.z); pm[6] = bflo(w.w); pm[7] = bfhi(w.w); }
            else {
#pragma unroll
                for (int e = 0; e < 8; ++e) pm[e] = cc15[c0 + e] * cx15[c0 + e]; }
            if (tl != T - 1) { const u32x4 w = *(const u32x4*)(P + (size_t)(t + 1) * D + c0); pp[0] = bflo(w.x); pp[1] = bfhi(w.x); pp[2] = bflo(w.y); pp[3] = bfhi(w.y); pp[4] = bflo(w.z); pp[5] = bfhi(w.z); pp[6] = bflo(w.w); pp[7] = bfhi(w.w); }
            else {
#pragma unroll
                for (int e = 0; e < 8; ++e) pp[e] = 0.f; }
            const float pc[8] = {bflo(p0.x), bfhi(p0.x), bflo(p0.y), bfhi(p0.y), bflo(p0.z), bfhi(p0.z), bflo(p0.w), bfhi(p0.w)};
            const float gg[8] = {bflo(gq.x), bfhi(gq.x), bflo(gq.y), bfhi(gq.y), bflo(gq.z), bfhi(gq.z), bflo(gq.w), bfhi(gq.w)};
            float y[8];
#pragma unroll
            for (int e = 0; e < 8; ++e) { const int c = c0 + e; y[e] = gg[e] * (F.conv_w[c] * pm[e] + F.conv_w[D + c] * pc[e] + F.conv_w[2 * D + c] * pp[e]); }
            *(u32x4*)(A2 + (size_t)t * (2 * D) + c0) = (u32x4){pk2(y[0], y[1]), pk2(y[2], y[3]), pk2(y[4], y[5]), pk2(y[6], y[7])};
            const u32x4 a = *(const u32x4*)(OF + (size_t)t * D + c0), bq = *(const u32x4*)(OB + (size_t)t * D + c0);
            const u32x4 rq = *(const u32x4*)(A2 + (size_t)t * (2 * D) + D + c0);
            float ov[8] = {bflo(a.x) + bflo(bq.x), bfhi(a.x) + bfhi(bq.x), bflo(a.y) + bflo(bq.y), bfhi(a.y) + bfhi(bq.y), bflo(a.z) + bflo(bq.z), bfhi(a.z) + bfhi(bq.z), bflo(a.w) + bflo(bq.w), bfhi(a.w) + bfhi(bq.w)};
            float ss = 0.f;
#pragma unroll
            for (int e = 0; e < 8; ++e) ss += ov[e] * ov[e];
#pragma unroll
            for (int o = 1; o < 32; o <<= 1) ss += __shfl_xor(ss, o);
            const float rstd = 1.0f / sqrtf(ss * (1.f / DV) + EPS);
            const float rr[8] = {bflo(rq.x), bfhi(rq.x), bflo(rq.y), bfhi(rq.y), bflo(rq.z), bfhi(rq.z), bflo(rq.w), bfhi(rq.w)};
            float z[8];
#pragma unroll
            for (int e = 0; e < 8; ++e) z[e] = ov[e] * rstd * F.gn[(c0 + e) & (DV - 1)] * rr[e];
            *(u32x4*)(A2 + (size_t)t * (2 * D) + D + c0) = (u32x4){pk2(z[0], z[1]), pk2(z[2], z[3]), pk2(z[4], z[5]), pk2(z[6], z[7])};
        }
    }
}
__device__ __forceinline__ void p6_final(Frame& F) {
    const int gw = F.vcu * NWAVES + F.wave, NGW = F.G * NWAVES;
    const float* stats = (const float*)(F.ws + WS_STATS);
    f32x4 gp[4];
#pragma unroll
    for (int q = 0; q < 4; ++q) gp[q] = *(const f32x4*)(F.g_post + 4 * F.lane + 256 * q);
    for (int m = gw; m < M; m += NGW) {
        const f32x4 s0 = *(const f32x4*)(stats + (size_t)m * 16), s1 = *(const f32x4*)(stats + (size_t)m * 16 + 4), s2 = *(const f32x4*)(stats + (size_t)m * 16 + 8), s3 = *(const f32x4*)(stats + (size_t)m * 16 + 12);
        const float ss = ((s0[0] + s0[1]) + (s0[2] + s0[3])) + ((s1[0] + s1[1]) + (s1[2] + s1[3])) + ((s2[0] + s2[1]) + (s2[2] + s2[3])) + ((s3[0] + s3[1]) + (s3[2] + s3[3]));
        const float rstd = 1.0f / sqrtf(ss * (1.f / D) + EPS);
        const float* xr = F.x + (size_t)m * D + 4 * F.lane; float* orow = F.out + (size_t)m * D + 4 * F.lane;
#pragma unroll
        for (int q = 0; q < 4; ++q) { const f32x4 xv = *(const f32x4*)(xr + 256 * q), rv = *(const f32x4*)(orow + 256 * q); *(f32x4*)(orow + 256 * q) = xv + rv * rstd * gp[q]; }
    }
}

__global__ void __launch_bounds__(NWAVES * 64, 2) fwd_kernel(Args args) {
    extern __shared__ __attribute__((aligned(16))) unsigned char lds_raw[];
    Frame F;
    F.lds = (LAS unsigned char*)lds_raw;
    F.tid = threadIdx.x; F.lane = F.tid & 63; F.wave = __builtin_amdgcn_readfirstlane(F.tid >> 6);
    F.G = gridDim.x; { const int bx = blockIdx.x; F.vcu = (F.G % 8 == 0) ? (bx % 8) * (F.G / 8) + bx / 8 : bx; }
    F.x = args.in[0]; F.meta = args.in[1]; F.g_pre = args.in[2]; F.w_in = args.in[3]; F.conv_w = args.in[4]; F.wgf = args.in[5]; F.bgf = args.in[6];
    F.wgb = args.in[7]; F.bgb = args.in[8]; F.gn = args.in[9]; F.w_oc = args.in[10]; F.w_og = args.in[11]; F.w_mo = args.in[12]; F.g_post = args.in[13];
    F.out = args.out; F.ws = args.ws;
    const int lo = args.ph_lo, hi = args.ph_hi;
#define IN(k) (lo <= (k) && (k) < hi)
#if ONE_LAUNCH
    cg::grid_group grid = cg::this_grid();
#define SEAM(k) do { if (IN(k) && IN((k) + 1)) grid.sync(); } while (0)
#else
#define SEAM(k) do { } while (0)
#endif
    unsigned char* ws = args.ws; unsigned char* dob = (unsigned char*)args.out;
    if (IN(0)) { p0_prologue(F); }
    SEAM(0);
    if (IN(1)) {
        pg8::Gemm g{(const bf16_t*)(dob + DO_U), (const bf16_t*)(ws + WS_WIN), M, NSLOT, D}; pg8::StaticOrder S; S.init(M, NSLOT, F.G, (int)blockIdx.x);
        pg8::EpiProj E{(bf16_t*)(ws + WS_P), (bf16_t*)(ws + WS_A2), (bf16_t*)(dob + DO_Q), (bf16_t*)(dob + DO_K), (bf16_t*)(ws + WS_V), (bf16_t*)(ws + WS_SA), (bf16_t*)(ws + WS_SB), (float*)(ws + WS_LR)};
        pg8::gemm_phase<pg8::EpiProj, pg8::StaticOrder>(F.lds, g, S, E);
    }
    SEAM(1);
    if (IN(2)) {
        gla::Tensors X{(const bf16_t*)(dob + DO_Q), (const bf16_t*)(dob + DO_K), (const bf16_t*)(ws + WS_V), (const float*)(ws + WS_LR),
                       (const bf16_t*)(ws + WS_META + META_K), (const bf16_t*)(ws + WS_META + META_V), (const float*)(ws + WS_META + META_LR),
                       F.wgf, F.bgf, F.wgb, F.bgb, (bf16_t*)(dob + DO_OF), (bf16_t*)(ws + WS_OB)};
        for (int u = (int)blockIdx.x; u < NB * NH * 2; u += F.G) gla::unit(F.lds, X, u >> 3, (u >> 1) & 3, u & 1);
    }
    SEAM(2);
    if (IN(3)) { p3_prep(F); }
    SEAM(3);
    if (IN(4)) {
        pg8::Gemm g{(const bf16_t*)(ws + WS_A2), (const bf16_t*)(ws + WS_WMG), M, D, 2 * D}; pg8::StaticOrder S; S.init(M, D, F.G, (int)blockIdx.x);
        pg8::EpiMerge E{(const bf16_t*)(ws + WS_SA), (const bf16_t*)(ws + WS_SB), (bf16_t*)(ws + WS_MERGED)};
        pg8::gemm_phase<pg8::EpiMerge, pg8::StaticOrder>(F.lds, g, S, E);
    }
    SEAM(4);
    if (IN(5)) {
        pg8::Gemm g{(const bf16_t*)(ws + WS_MERGED), (const bf16_t*)(ws + WS_WOUT), M, D, D}; pg8::StaticOrder S; S.init(M, D, F.G, (int)blockIdx.x);
        pg8::EpiOut E{F.out, (float*)(ws + WS_STATS)};
        pg8::gemm_phase<pg8::EpiOut, pg8::StaticOrder>(F.lds, g, S, E);
    }
    SEAM(5);
    if (IN(6)) { p6_final(F); }
#undef IN
#undef SEAM
}

extern "C" void kernel_launch(void* const* d_in, const int* in_sizes, int n_in, void* d_out, int out_size, void* d_ws, size_t ws_size, hipStream_t stream) {
    static int grid = 0;
    if (grid == 0) {
        if (n_in != 14 || in_sizes[0] != M * D || out_size != M * D || ws_size < WS_END) {
            fprintf(stderr, "kernel_launch: unexpected shapes (n_in %d, in0 %d, out %d, ws %zu; need ws >= %zu); nothing launched\n", n_in, n_in > 0 ? in_sizes[0] : -1, out_size, ws_size, (size_t)WS_END); grid = -1; return; }
        int dev = 0, cus = 0, per_cu = 0;
        if (hipGetDevice(&dev) != hipSuccess || hipDeviceGetAttribute(&cus, hipDeviceAttributeMultiprocessorCount, dev) != hipSuccess) { grid = -1; return; }
        if (hipFuncSetAttribute((const void*)fwd_kernel, hipFuncAttributeMaxDynamicSharedMemorySize, LDS_BYTES) != hipSuccess) { fprintf(stderr, "kernel_launch: hipFuncSetAttribute failed\n"); grid = -1; return; }
        if (hipOccupancyMaxActiveBlocksPerMultiprocessor(&per_cu, (const void*)fwd_kernel, NWAVES * 64, LDS_BYTES) != hipSuccess || per_cu < 1) { fprintf(stderr, "kernel_launch: occupancy query says %d blocks per CU\n", per_cu); per_cu = 1; }
        (void)hipGetLastError();
        grid = cus;
    }
    if (grid < 0) return;
    Args a{};
    for (int i = 0; i < 14; ++i) a.in[i] = (const float*)d_in[i];
    a.out = (float*)d_out; a.ws = (unsigned char*)d_ws;
#if ONE_LAUNCH
    a.ph_lo = 0; a.ph_hi = 7;
    void* params[] = {&a};
    hipError_t e = hipLaunchCooperativeKernel((const void*)fwd_kernel, dim3(grid), dim3(NWAVES * 64), params, LDS_BYTES, stream);
    if (e != hipSuccess) fprintf(stderr, "kernel_launch: cooperative launch failed: %s (grid %d)\n", hipGetErrorString(e), grid);
#else
    for (int p = 0; p < 7; ++p) { a.ph_lo = p; a.ph_hi = p + 1; hipLaunchKernelGGL(fwd_kernel, dim3(grid), dim3(NWAVES * 64), LDS_BYTES, stream, a); }
#endif
}
```

```cpp
#include <hip/hip_runtime.h>
#include <hip/hip_cooperative_groups.h>
#include <cstdio>
#include <cstdint>
namespace cg = cooperative_groups;

#define LAS __attribute__((address_space(3)))
typedef unsigned short bf16_t;
typedef short bf16x8 __attribute__((ext_vector_type(8)));
typedef short s16x4 __attribute__((ext_vector_type(4)));
typedef float f32x4 __attribute__((ext_vector_type(4)));
typedef float f32x2 __attribute__((ext_vector_type(2)));
typedef float f32x16 __attribute__((ext_vector_type(16)));
typedef unsigned u32x4 __attribute__((ext_vector_type(4)));
typedef unsigned u32x2 __attribute__((ext_vector_type(2)));
typedef __bf16 bf2_t __attribute__((ext_vector_type(2)));

__device__ __forceinline__ unsigned pk2(float lo, float hi) { f32x2 v = {lo, hi}; bf2_t b = __builtin_convertvector(v, bf2_t); return __builtin_bit_cast(unsigned, b); }
__device__ __forceinline__ float bflo(unsigned w) { return __builtin_bit_cast(float, w << 16); }
__device__ __forceinline__ float bfhi(unsigned w) { return __builtin_bit_cast(float, w & 0xffff0000u); }
__device__ __forceinline__ float sigm(float x) { return __builtin_amdgcn_rcpf(1.f + __expf(-x)); }
#define LDS_WAIT() asm volatile("s_waitcnt lgkmcnt(0)" ::: "memory")
#define LBAR() do { asm volatile("s_waitcnt lgkmcnt(0)" ::: "memory"); __builtin_amdgcn_s_barrier(); asm volatile("" ::: "memory"); } while (0)

typedef __amdgpu_buffer_rsrc_t rsrc_t;
typedef unsigned v4u_t __attribute__((__vector_size__(16)));
__device__ __forceinline__ rsrc_t mk_rsrc(const void* p, unsigned bytes) { return __builtin_amdgcn_make_buffer_rsrc((void*)p, (short)0, (int)bytes, 0x00020000); }
__device__ __forceinline__ u32x4 bld128(rsrc_t r, unsigned voff, unsigned soff) { return __builtin_bit_cast(u32x4, __builtin_amdgcn_raw_buffer_load_b128(r, (int)voff, (int)soff, 0)); }
__device__ __forceinline__ void bst128(u32x4 v, rsrc_t r, unsigned voff, unsigned soff) { __builtin_amdgcn_raw_buffer_store_b128(__builtin_bit_cast(v4u_t, v), r, (int)voff, (int)soff, 0); }

constexpr int NB = 32, T = 2048, D = 1024, M = NB * T;
constexpr int NIN = 9248, NSLOT = 9472;
constexpr int NH = 4, DK = 128, DV = 256, CH = 64;
constexpr float EPS = 1e-6f;
constexpr int O_CB = 0, O_CC = 1024, O_CX = 2048, O_CZ = 3072, O_Q = 4096, O_K = 4608, O_V = 5120, O_R = 6144, O_LRF = 7168, O_LRB = 7184, O_MA = 7200, O_MB = 8224;

constexpr size_t MiB = 1u << 20;
constexpr size_t WS_WIN = 1 * MiB, WS_WMG = 20 * MiB, WS_WOUT = 24 * MiB, WS_META = 26 * MiB, WS_LR = 27 * MiB, WS_STATS = 35 * MiB;
constexpr size_t WS_P = 64 * MiB, WS_A2 = 192 * MiB, WS_V = 448 * MiB, WS_SA = 576 * MiB, WS_SB = 704 * MiB, WS_OB = 832 * MiB, WS_END = 960 * MiB;
constexpr size_t WS_SIDEP = 40 * MiB, WS_SIDEG = 44 * MiB;
constexpr size_t WS_MERGED = WS_OB;
constexpr size_t WS_U = WS_P, WS_RMS = 52 * MiB;
constexpr size_t WS_RAW = WS_V;
constexpr size_t META_K = 0, META_V = 65536, META_LR = 65536 + 131072, META_CC = META_LR + 8192, META_CX = META_CC + 4096;
constexpr size_t DO_U = 0, DO_OF = 0, DO_Q = 128 * MiB, DO_K = 192 * MiB;

namespace pg8 {
constexpr int BM = 256, BK = 64, HALF = 128, HTB = HALF * BK * 2, STAGE_BYTES = 8 * HTB, NXCD = 8, WGM = 8;
__host__ __device__ __forceinline__ int lds_byte(int r, int c) { const int st = (r >> 4) * 2 + (c >> 5), rr = r & 15, cc = c & 31, ob = rr * 64 + cc * 2; return st * 1024 + (ob ^ (((ob >> 9) & 1) << 5)); }
__host__ __device__ __forceinline__ void stage_rc(int b, int& R, int& C) { const int st = b / 1024, sb = b % 1024, swz = sb ^ (((sb >> 9) & 1) << 5); R = (st >> 1) * 16 + swz / 64; C = (st & 1) * 32 + (swz % 64) / 2; }
struct Unit { int pm, pn; };
struct Gemm { const bf16_t* A; const bf16_t* Bt; int M, N, K; };
struct StaticOrder {
    int nM, nN, nwg, G, c;
    __host__ __device__ void init(int M_, int N_, int G_, int c_) { nM = M_ / BM; nN = N_ / BM; nwg = nM * nN; G = G_; c = c_; }
    __host__ __device__ bool next(int i, Unit& u) const {
        const long L = (long)i * G + c; if (L >= nwg) return false;
        int wgid = (int)L; { const int q = nwg / NXCD, r = nwg % NXCD, xcd = wgid % NXCD, off = wgid / NXCD; wgid = (xcd < r ? xcd * (q + 1) : r * (q + 1) + (xcd - r) * q) + off; }
        const int nig = WGM * nN, gid = wgid / nig, fm = gid * WGM, gsz = (nM - fm) < WGM ? (nM - fm) : WGM;
        u.pm = fm + ((wgid % nig) % gsz); u.pn = (wgid % nig) / gsz; return true;
    }
};

__device__ __forceinline__ float sig_fast(float x) { return __builtin_amdgcn_rcpf(1.f + __builtin_amdgcn_exp2f(-1.4426950408889634f * x)); }
struct EpiProj {
    static constexpr bool AFTER_DRAIN = false, MID = false;
    bf16_t *SIDEP, *SIDEG, *A2, *Q, *K, *V, *RA, *SB; float* LR; const float* convw; LAS unsigned char* stage;
    __device__ __forceinline__ void mid(f32x4 (&)[2][2][4][2], const Unit&, int, int, int, int) const {}
    __device__ __forceinline__ void plain(const f32x4 (&acc)[2][2][4][2], bf16_t* base, int ld, int row0, int col0, float scale) const {
#pragma unroll
        for (int ai = 0; ai < 2; ++ai)
#pragma unroll
            for (int m = 0; m < 4; ++m) {
                bf16_t* rowp = base + (size_t)(row0 + ai * HALF + m * 16) * ld + col0;
#pragma unroll
                for (int bj = 0; bj < 2; ++bj) {
                    const f32x4 v0 = acc[ai][bj][m][0] * scale, v1 = acc[ai][bj][m][1] * scale;
                    *(u32x4*)(rowp + bj * HALF) = (u32x4){pk2(v0[0], v0[1]), pk2(v0[2], v0[3]), pk2(v1[0], v1[1]), pk2(v1[2], v1[3])};
                }
            }
    }
    __device__ __forceinline__ void operator()(const f32x4 (&acc)[2][2][4][2], const Unit& u, int wr, int wc, int fr, int fq) const {
        const int row0 = u.pm * BM + wr * 64 + fr; const int pn = u.pn;
        if (pn < 16) {
            const int ch0 = pn * 64 + wc * 16 + fq * 4;
            const f32x4 w0 = *(const f32x4*)(convw + ch0), w1 = *(const f32x4*)(convw + D + ch0), w2 = *(const f32x4*)(convw + 2 * D + ch0);
            LAS unsigned char* stg = stage + (fr + 1) * 32 + fq * 8;
#pragma unroll
            for (int ai = 0; ai < 2; ++ai) {
                f32x4 p[4], g[4];
#pragma unroll
                for (int m = 0; m < 4; ++m) {
                    const f32x4 cb = acc[ai][0][m][0], cc = acc[ai][0][m][1], cx = acc[ai][1][m][0], cz = acc[ai][1][m][1];
                    p[m] = cc * cx; g[m] = cb * cz;
#pragma unroll
                    for (int e = 0; e < 4; ++e) g[m][e] *= sig_fast(cz[e]);
                    *(LAS u32x2*)(stg + m * 512) = (u32x2){pk2(p[m][0], p[m][1]), pk2(p[m][2], p[m][3])};
                }
                asm volatile("s_waitcnt lgkmcnt(0)" ::: "memory");
                const int run = u.pm * 4 + ai * 2 + wr;
#pragma unroll
                for (int m = 0; m < 4; ++m) {
                    const size_t row = (size_t)(row0 + ai * HALF + m * 16);
                    const u32x2 a = *(const LAS u32x2*)(stg + m * 512 - 32), b = *(const LAS u32x2*)(stg + m * 512 + 32);
                    const f32x4 pm = {bflo(a.x), bfhi(a.x), bflo(a.y), bfhi(a.y)}, pp = {bflo(b.x), bfhi(b.x), bflo(b.y), bfhi(b.y)};
                    const f32x4 y = g[m] * (w0 * pm + w1 * p[m] + w2 * pp);
                    *(u32x2*)(A2 + row * (2 * D) + ch0) = (u32x2){pk2(y[0], y[1]), pk2(y[2], y[3])};
                    if ((m == 0 && fr == 0) || (m == 3 && fr == 15)) {
                        const size_t so = ((size_t)run * 2 + (m == 3 ? 1 : 0)) * D + ch0;
                        *(u32x2*)(SIDEP + so) = (u32x2){pk2(p[m][0], p[m][1]), pk2(p[m][2], p[m][3])};
                        *(u32x2*)(SIDEG + so) = (u32x2){pk2(g[m][0], g[m][1]), pk2(g[m][2], g[m][3])};
                    }
                }
                asm volatile("" ::: "memory");
            }
        } else if (pn < 24) {
            const int col0 = wc * 32 + fq * 8;
            if (pn < 18)      plain(acc, Q, 512, row0, (pn - 16) * 256 + col0, 0.08838834764831845f);
            else if (pn < 20) plain(acc, K, 512, row0, (pn - 18) * 256 + col0, 1.f);
            else              plain(acc, V, D, row0, (pn - 20) * 256 + col0, 1.f);
        } else if (pn < 28) {
            plain(acc, A2, 2 * D, row0, D + (pn - 24) * 256 + wc * 32 + fq * 8, 1.f);
        } else if (pn < 36) {
            const int col0 = (pn - 28) * 128 + wc * 32 + fq * 8;
#pragma unroll
            for (int ai = 0; ai < 2; ++ai)
#pragma unroll
                for (int m = 0; m < 4; ++m) {
                    const size_t off = (size_t)(row0 + ai * HALF + m * 16) * D + col0;
                    float ra[8], sb[8];
#pragma unroll
                    for (int n = 0; n < 2; ++n)
#pragma unroll
                        for (int e = 0; e < 4; ++e) {
                            const float ea = 1.f + __builtin_amdgcn_exp2f(-1.4426950408889634f * acc[ai][0][m][n][e]), eb = 1.f + __builtin_amdgcn_exp2f(-1.4426950408889634f * acc[ai][1][m][n][e]);
                            ra[4 * n + e] = eb * __builtin_amdgcn_rcpf(ea); sb[4 * n + e] = __builtin_amdgcn_rcpf(eb);
                        }
                    *(u32x4*)(RA + off) = (u32x4){pk2(ra[0], ra[1]), pk2(ra[2], ra[3]), pk2(ra[4], ra[5]), pk2(ra[6], ra[7])};
                    *(u32x4*)(SB + off) = (u32x4){pk2(sb[0], sb[1]), pk2(sb[2], sb[3]), pk2(sb[4], sb[5]), pk2(sb[6], sb[7])};
                }
        } else {
            if (wc == 0) {
#pragma unroll
                for (int ai = 0; ai < 2; ++ai)
#pragma unroll
                    for (int m = 0; m < 4; ++m) {
                        float* rowp = LR + (size_t)(row0 + ai * HALF + m * 16) * 32 + 4 * fq;
                        *(f32x4*)(rowp) = acc[ai][0][m][0]; *(f32x4*)(rowp + 16) = acc[ai][0][m][1];
                    }
            }
        }
    }
};
struct EpiMerge {
    static constexpr bool AFTER_DRAIN = false, MID = true;
    const bf16_t *SA, *SB; bf16_t* O;
    __device__ __forceinline__ void mid(f32x4 (&acc)[2][2][4][2], const Unit& u, int wr, int wc, int fr, int fq) const {
        const rsrc_t ra = mk_rsrc(SA, (unsigned)((size_t)M * D * 2));
        const unsigned voff = (unsigned)((wr * 64 + fr) * D + wc * 32 + fq * 8) * 2u;
        const unsigned uoff = (unsigned)(u.pm * BM * D + u.pn * BM) * 2u;
#pragma unroll
        for (int ai = 0; ai < 2; ++ai)
#pragma unroll
            for (int m = 0; m < 4; ++m)
#pragma unroll
                for (int bj = 0; bj < 2; ++bj) {
                    const unsigned so = uoff + (unsigned)((ai * HALF + m * 16) * D + bj * HALF) * 2u;
                    const u32x4 a = bld128(ra, voff, so);
                    acc[ai][bj][m][0] *= (f32x4){bflo(a.x), bfhi(a.x), bflo(a.y), bfhi(a.y)}; acc[ai][bj][m][1] *= (f32x4){bflo(a.z), bfhi(a.z), bflo(a.w), bfhi(a.w)};
                }
    }
    __device__ __forceinline__ void operator()(const f32x4 (&acc)[2][2][4][2], const Unit& u, int wr, int wc, int fr, int fq) const {
        const rsrc_t rb = mk_rsrc(SB, (unsigned)((size_t)M * D * 2)), ro = mk_rsrc(O, (unsigned)((size_t)M * D * 2));
        const unsigned voff = (unsigned)((wr * 64 + fr) * D + wc * 32 + fq * 8) * 2u;
        const unsigned uoff = (unsigned)(u.pm * BM * D + u.pn * BM) * 2u;
#pragma unroll
        for (int ai = 0; ai < 2; ++ai)
#pragma unroll
            for (int m = 0; m < 4; ++m)
#pragma unroll
                for (int bj = 0; bj < 2; ++bj) {
                    const unsigned so = uoff + (unsigned)((ai * HALF + m * 16) * D + bj * HALF) * 2u;
                    const u32x4 b = bld128(rb, voff, so);
                    const f32x4 v0 = acc[ai][bj][m][0], v1 = acc[ai][bj][m][1];
                    u32x4 w;
                    w.x = pk2(v0[0] * bflo(b.x), v0[1] * bfhi(b.x)); w.y = pk2(v0[2] * bflo(b.y), v0[3] * bfhi(b.y));
                    w.z = pk2(v1[0] * bflo(b.z), v1[1] * bfhi(b.z)); w.w = pk2(v1[2] * bflo(b.w), v1[3] * bfhi(b.w));
                    bst128(w, ro, voff, so);
                }
    }
};
struct EpiOut {
    static constexpr bool AFTER_DRAIN = false, MID = false;
    bf16_t* C; float* stats;
    __device__ __forceinline__ void mid(f32x4 (&)[2][2][4][2], const Unit&, int, int, int, int) const {}
    __device__ __forceinline__ void operator()(const f32x4 (&acc)[2][2][4][2], const Unit& u, int wr, int wc, int fr, int fq) const {
        const int row0 = u.pm * BM + wr * 64 + fr, col0 = u.pn * BM + wc * 32 + 8 * fq;
#pragma unroll
        for (int ai = 0; ai < 2; ++ai)
#pragma unroll
            for (int m = 0; m < 4; ++m) {
                const size_t row = (size_t)(row0 + ai * HALF + m * 16);
                bf16_t* rowp = C + row * D + col0; float s = 0.f;
#pragma unroll
                for (int bj = 0; bj < 2; ++bj) {
                    const f32x4 v0 = acc[ai][bj][m][0], v1 = acc[ai][bj][m][1];
                    s += ((v0[0] * v0[0] + v0[1] * v0[1]) + (v0[2] * v0[2] + v0[3] * v0[3])) + ((v1[0] * v1[0] + v1[1] * v1[1]) + (v1[2] * v1[2] + v1[3] * v1[3]));
                    *(u32x4*)(rowp + bj * HALF) = (u32x4){pk2(v0[0], v0[1]), pk2(v0[2], v0[3]), pk2(v1[0], v1[1]), pk2(v1[2], v1[3])};
                }
                s += __shfl_xor(s, 16); s += __shfl_xor(s, 32);
                if (fq == 0) stats[row * 16 + u.pn * 4 + wc] = s;
            }
    }
};

template <class Epi, class Sched>
__device__ __forceinline__ void gemm_phase(LAS unsigned char* lds, const Gemm g, const Sched& S, const Epi& E) {
    const int tid = threadIdx.x, wid = __builtin_amdgcn_readfirstlane(tid >> 6), lane = tid & 63, wr = wid >> 2, wc = wid & 3, fr = lane & 15, fq = lane >> 4;
    const int K = g.K, nt = K / BK;
    unsigned voffA[2];
#pragma unroll
    for (int i = 0; i < 2; ++i) { int R, C; stage_rc(tid * 16 + i * 8192, R, C); voffA[i] = (unsigned)(R * K + C) * 2u; }
    const size_t kstep = (size_t)(BK * 2);
    const size_t hstep = (size_t)HALF * K * 2;
    const size_t tstep = 2 * hstep;
    const unsigned ldsw = (unsigned)wid * 1024u;
    const int aoff = lds_byte(wr * 64 + fr, fq * 8), boff = lds_byte(wc * 32 + fr, fq * 8);
#define PG8_SA(b, h) (((b) * 2 + (h)) * HTB)
#define PG8_SB(b, h) ((4 + (b) * 2 + (h)) * HTB)
#define PG8_STAGE(bufoff, gbase) do { _Pragma("unroll") for (int _i = 0; _i < 2; ++_i) \
        __builtin_amdgcn_global_load_lds((const unsigned*)((const char*)(gbase) + voffA[_i]), (LAS unsigned*)(lds + (bufoff) + ldsw + _i * 8192), 16, 0, 0); } while (0)
#define PG8_LDA(dst, b, h) do { _Pragma("unroll") for (int m = 0; m < 4; ++m) _Pragma("unroll") for (int k = 0; k < 2; ++k) dst[m][k] = *(const LAS bf16x8*)(lds + PG8_SA(b, h) + aoff + m * 2048 + k * 1024); } while (0)
#define PG8_LDB(dst, b, h) do { _Pragma("unroll") for (int n = 0; n < 2; ++n) _Pragma("unroll") for (int k = 0; k < 2; ++k) dst[n][k] = *(const LAS bf16x8*)(lds + PG8_SB(b, h) + boff + n * 2048 + k * 1024); } while (0)
#define PG8_MMA(ai, bj, At, Bt) do { __builtin_amdgcn_s_setprio(1); _Pragma("unroll") for (int m = 0; m < 4; ++m) _Pragma("unroll") for (int n = 0; n < 2; ++n) _Pragma("unroll") for (int k = 0; k < 2; ++k) \
        acc[ai][bj][m][n] = __builtin_amdgcn_mfma_f32_16x16x32_bf16(Bt[n][k], At[m][k], acc[ai][bj][m][n], 0, 0, 0); __builtin_amdgcn_s_setprio(0); } while (0)
#define PG8_WAIT_V(n) asm volatile("s_waitcnt vmcnt(" #n ")" ::: "memory")
#define PG8_WAIT_L(n) asm volatile("s_waitcnt lgkmcnt(" #n ")" ::: "memory")
#define PG8_BAR __builtin_amdgcn_s_barrier()
#define PG8_SCHED __builtin_amdgcn_sched_barrier(0)
    Unit cur, nxt; int ui = 0;
    if (!S.next(0, cur)) return;
    f32x4 acc[2][2][4][2];
#pragma unroll
    for (int a = 0; a < 2; ++a)
#pragma unroll
        for (int b = 0; b < 2; ++b)
#pragma unroll
            for (int m = 0; m < 4; ++m)
#pragma unroll
                for (int n = 0; n < 2; ++n) acc[a][b][m][n] = (f32x4){0.f, 0.f, 0.f, 0.f};
    bf16x8 At[4][2], B0[2][2], B1[2][2];
    const char* cA = (const char*)g.A + (size_t)cur.pm * tstep; const char* cB = (const char*)g.Bt + (size_t)cur.pn * tstep;
    PG8_STAGE(PG8_SB(0, 0), cB); PG8_STAGE(PG8_SB(0, 1), cB + hstep); PG8_STAGE(PG8_SA(0, 0), cA); PG8_STAGE(PG8_SA(0, 1), cA + hstep);
    if (wr == 1) PG8_BAR;
    PG8_WAIT_V(2); PG8_BAR;
    PG8_STAGE(PG8_SB(1, 0), cB + kstep); PG8_STAGE(PG8_SA(1, 0), cA + kstep); PG8_STAGE(PG8_SB(1, 1), cB + hstep + kstep);
    PG8_WAIT_V(6); PG8_BAR;
    for (;;) {
        const bool has_next = S.next(ui + 1, nxt);
        const char* nA = has_next ? (const char*)g.A + (size_t)nxt.pm * tstep : cA; const char* nB = has_next ? (const char*)g.Bt + (size_t)nxt.pn * tstep : cB;
        for (int part = 0; part < (Epi::MID ? 2 : 1); ++part) {
        const int t_lo = part ? (nt >> 1) : 0, t_hi = (Epi::MID && part == 0) ? (nt >> 1) : nt;
        if constexpr (Epi::MID) { if (part == 1) E.mid(acc, cur, wr, wc, fr, fq); }
        for (int t = t_lo; t < t_hi; t += 2) {
            const bool last = (t == nt - 2);
            const char* a1 = cA + (size_t)(t + 1) * kstep;
            const char* a2 = last ? nA : cA + (size_t)(t + 2) * kstep; const char* b2 = last ? nB : cB + (size_t)(t + 2) * kstep;
            const char* a3 = a2 + kstep; const char* b3 = b2 + kstep;
            PG8_LDB(B0, 0, 0); PG8_LDB(B1, 0, 1); PG8_SCHED; PG8_LDA(At, 0, 0); PG8_STAGE(PG8_SA(1, 1), a1 + hstep);
            PG8_WAIT_V(8); PG8_WAIT_L(0); PG8_BAR; PG8_MMA(0, 0, At, B0); PG8_MMA(0, 1, At, B1); PG8_BAR; PG8_SCHED;
            PG8_LDA(At, 0, 1); PG8_STAGE(PG8_SB(0, 0), b2); PG8_STAGE(PG8_SB(0, 1), b2 + hstep); PG8_STAGE(PG8_SA(0, 0), a2);
            PG8_WAIT_V(8); PG8_WAIT_L(0); PG8_BAR; PG8_MMA(1, 0, At, B0); PG8_MMA(1, 1, At, B1); PG8_BAR; PG8_SCHED;
            PG8_LDB(B0, 1, 0); PG8_LDB(B1, 1, 1); PG8_SCHED; PG8_LDA(At, 1, 0); PG8_STAGE(PG8_SA(0, 1), a2 + hstep);
            PG8_WAIT_V(8); PG8_WAIT_L(0); PG8_BAR; PG8_MMA(0, 0, At, B0); PG8_MMA(0, 1, At, B1); PG8_BAR; PG8_SCHED;
            PG8_LDA(At, 1, 1); PG8_STAGE(PG8_SB(1, 0), b3); PG8_STAGE(PG8_SB(1, 1), b3 + hstep); PG8_STAGE(PG8_SA(1, 0), a3);
            PG8_WAIT_V(8); PG8_WAIT_L(0); PG8_BAR; PG8_MMA(1, 0, At, B0); PG8_MMA(1, 1, At, B1); PG8_BAR; PG8_SCHED;
        }
        }
        if (wr == 0) PG8_BAR;
        E(acc, cur, wr, wc, fr, fq);
        if (!has_next) break;
#pragma unroll
        for (int a = 0; a < 2; ++a)
#pragma unroll
            for (int b = 0; b < 2; ++b)
#pragma unroll
                for (int m = 0; m < 4; ++m)
#pragma unroll
                    for (int n = 0; n < 2; ++n) acc[a][b][m][n] = (f32x4){0.f, 0.f, 0.f, 0.f};
        cur = nxt; cA = nA; cB = nB; ++ui;
        if (wr == 1) PG8_BAR;
    }
    PG8_WAIT_V(0);
    PG8_BAR;
#undef PG8_SA
#undef PG8_SB
#undef PG8_STAGE
#undef PG8_LDA
#undef PG8_LDB
#undef PG8_MMA
#undef PG8_WAIT_V
#undef PG8_WAIT_L
#undef PG8_BAR
#undef PG8_SCHED
}
}

#define XB_TMO      128
#define XB_XCNT(j)  (256  + 64 * (j))
#define XB_XSUB(j)  (1280 + 64 * (j))
#define XB_XGEN(j)  (2304 + 64 * (j))
#define XB_TOP      3328
#define XB_TOPGEN   3392
#define XCD_BAR_WORDS 3456
#define XB_SPIN_CAP (1u << 18)
__device__ __forceinline__ unsigned xb_ld(unsigned* p)              { return __hip_atomic_load(p, __ATOMIC_RELAXED, __HIP_MEMORY_SCOPE_AGENT); }
__device__ __forceinline__ unsigned xb_add(unsigned* p, unsigned v) { return __hip_atomic_fetch_add(p, v, __ATOMIC_RELAXED, __HIP_MEMORY_SCOPE_AGENT); }
__device__ __forceinline__ unsigned xb_xcc_id() { return (unsigned)__builtin_amdgcn_s_getreg((3 << 11) | 20) & 0xFu; }
#define XB_SPIN(cond, bar) do { unsigned _sp = 0; while (cond) { __builtin_amdgcn_s_sleep(1); \
    if ((++_sp & 255u) == 0u) { if (xb_ld(&(bar)[XB_TMO])) break; if (_sp > XB_SPIN_CAP) { atomicAdd(&(bar)[XB_TMO], 1u); break; } } } } while (0)
struct XcdBarrier { unsigned* bar; unsigned x; volatile LAS unsigned* st; };
__device__ __forceinline__ XcdBarrier xcd_barrier_post(unsigned* bar, volatile LAS unsigned* st) {
    XcdBarrier b; b.bar = bar; b.x = xb_xcc_id(); b.st = st;
    if (threadIdx.x == 0) (void)xb_add(&bar[XB_XCNT(b.x)], 1u);
    return b;
}
__device__ __forceinline__ void xcd_barrier_complete(unsigned* bar, unsigned x, unsigned& nloc, unsigned& nx) {
    const unsigned G = gridDim.x * gridDim.y * gridDim.z;
    unsigned sum, cnt, mine, sp = 0u;
    for (;;) {
        sum = 0u; cnt = 0u; mine = 0u;
#pragma unroll
        for (unsigned j = 0; j < 16; ++j) { const unsigned c = xb_ld(&bar[XB_XCNT(j)]); sum += c; cnt += (c > 0u) ? 1u : 0u; mine = (j == x) ? c : mine; }
        if (sum == G) break;
        __builtin_amdgcn_s_sleep(1);
        if ((++sp & 255u) == 0u) { if (xb_ld(&bar[XB_TMO])) break; if (sp > XB_SPIN_CAP) { atomicAdd(&bar[XB_TMO], 1u); break; } }
    }
    nloc = mine > 0u ? mine : 1u; nx = cnt > 0u ? cnt : 1u;
}
__device__ __forceinline__ void xcd_barrier(const XcdBarrier& b) {
    asm volatile("s_waitcnt vmcnt(0)" ::: "memory");
    __syncthreads();
    if (threadIdx.x == 0) {
        unsigned* bar = b.bar;
        __builtin_amdgcn_s_waitcnt(0);
        unsigned nloc = b.st[0], nx = b.st[1];
        if (nloc == 0u) { xcd_barrier_complete(bar, b.x, nloc, nx); b.st[0] = nloc; b.st[1] = nx; }
        const unsigned old = xb_add(&bar[XB_XSUB(b.x)], 1u);
        const unsigned gen = old / nloc;
        if (old + 1u == (gen + 1u) * nloc) {
            __builtin_amdgcn_fence(__ATOMIC_RELEASE, "agent");
            asm volatile("s_waitcnt vmcnt(0)" ::: "memory");
            const unsigned og = xb_add(&bar[XB_TOP], 1u);
            const unsigned tg = og / nx;
            if (og + 1u == (tg + 1u) * nx) xb_add(&bar[XB_TOPGEN], 1u);
            else XB_SPIN(xb_ld(&bar[XB_TOPGEN]) == tg, bar);
            __builtin_amdgcn_fence(__ATOMIC_ACQUIRE, "agent");
            xb_add(&bar[XB_XGEN(b.x)], 1u);
            asm volatile("s_waitcnt vmcnt(0)" ::: "memory");
        } else {
            XB_SPIN(xb_ld(&bar[XB_XGEN(b.x)]) == gen, bar);
            __builtin_amdgcn_fence(__ATOMIC_ACQUIRE, "agent");
            asm volatile("s_waitcnt vmcnt(0)" ::: "memory");
        }
    }
    __syncthreads();
}

namespace gla {
constexpr int QS = 272, SS = 144;
constexpr int L_QI = 0, L_KI = 17408, L_KD = 34816, L_V = 51200, L_ST = 83968, L_E = 93184, L_TOTP = 125952, L_DEC = 126976, L_O = 128000, L_GN = 160768, L_END = 161792;
__device__ __forceinline__ int v_st(int k, int c) { const int kk = (k & ~0xC) | ((k & 4) << 1) | ((k & 8) >> 1); return ((kk >> 3) * 4 + (c >> 5)) * 512 + ((kk & 7) * 32 + (c & 31)) * 2; }
__device__ __forceinline__ int v_rd_base(int lane) { return ((lane & 3) << 3) | (((lane >> 2) & 3) << 6) | (((lane >> 4) & 1) << 5) | (((lane >> 5) & 1) << 8); }
__host__ __device__ constexpr int v_rd_off(int d0, int ks, int half) { return d0 * 512 + ks * 4096 + half * 2048; }
__device__ __forceinline__ s16x4 tr_read(const LAS unsigned char* p) { return __builtin_bit_cast(s16x4, __builtin_amdgcn_ds_read_tr16_b64_v4i16((LAS s16x4*)p)); }
__device__ __forceinline__ bf16x8 cat8(s16x4 lo, s16x4 hi) { return __builtin_shufflevector(lo, hi, 0, 1, 2, 3, 4, 5, 6, 7); }
#define MFMA32(a, b, c) __builtin_amdgcn_mfma_f32_32x32x16_bf16((a), (b), (c), 0, 0, 0)
#define MFMA16(a, b, c) __builtin_amdgcn_mfma_f32_16x16x32_bf16((a), (b), (c), 0, 0, 0)

struct Tensors {
    const bf16_t *Q, *K, *V; const float* LR;
    const bf16_t *Kmeta, *Vmeta; const float* LRmeta;
    const float *wgf, *bgf, *wgb, *bgb;
    bf16_t *OF, *OB;
    bf16_t* A2; const float* gn;
};

__device__ __forceinline__ void unit(LAS unsigned char* lds, const Tensors& X, int b, int h, int dir, const XcdBarrier& xbar) {
    const int tid = threadIdx.x, lane = tid & 63, wid = __builtin_amdgcn_readfirstlane(tid >> 6), r32 = lane & 31, hi = lane >> 5;
    const int nsteps = dir ? 32 : 33, nmid = dir ? 16 : 17;
    if (tid < 64) *(LAS f32x4*)(lds + L_GN + tid * 16) = *(const f32x4*)(X.gn + tid * 4);
    if (wid < 4) {
        const int w = wid;
        f32x16 S[2][4];
#pragma unroll
        for (int ex = 0; ex < 2; ++ex)
#pragma unroll
            for (int i = 0; i < 4; ++i)
#pragma unroll
                for (int r = 0; r < 16; ++r) S[ex][i][r] = 0.f;
        const LAS unsigned char* const r_sc = lds + (lane & 15) * QS + (lane >> 4) * 16;
        LAS unsigned char* const w_st = lds + L_ST + (lane & 15) * SS + (lane >> 4) * 8;
        const LAS unsigned char* const r_qi = lds + L_QI + r32 * QS + hi * 8;
        const LAS unsigned char* const r_st = lds + L_ST + r32 * SS + hi * 16;
        const LAS unsigned char* const r_dec = lds + L_DEC + hi * 16;
        const LAS unsigned char* const vb0 = lds + L_V + (w >> 1) * 16384 + ((2 * w) & 3) * 512 + v_rd_base(lane);
        const LAS unsigned char* const kdbase = lds + L_KD + v_rd_base(lane);
        LAS unsigned char* const w_o = lds + L_O + (4 * hi) * 512 + (64 * w + r32) * 2;
        for (int n = -1; n < nsteps; ++n) {
            if (n == nmid) xcd_barrier(xbar);
            const bool second = n >= nmid;
            const int parM = (n & 1) * 512;
#pragma unroll
            for (int ti = 0; ti < 4; ++ti) {
                const int tj = w;
                f32x4 sc = {0.f, 0.f, 0.f, 0.f};
                if (dir == 0 ? (tj <= ti) : (tj >= ti)) {
                    const LAS unsigned char* pa = r_sc + L_KI + tj * (16 * QS); const LAS unsigned char* pb = r_sc + L_QI + ti * (16 * QS);
#pragma unroll
                    for (int ks = 0; ks < 4; ++ks) sc = MFMA16(*(const LAS bf16x8*)(pa + ks * 64), *(const LAS bf16x8*)(pb + ks * 64), sc);
                }
                const int i = 16 * ti + (lane & 15), j0 = 16 * tj + 4 * (lane >> 4);
#pragma unroll
                for (int r = 0; r < 4; ++r) { const int j = j0 + r; const bool keep = dir == 0 ? (j <= i) : (j > i); if (!keep) sc[r] = 0.f; }
                *(LAS u32x2*)(w_st + ti * (16 * SS) + tj * 32) = (u32x2){pk2(sc[0], sc[1]), pk2(sc[2], sc[3])};
            }
            f32x16 o[2][2];
#pragma unroll
            for (int ex = 0; ex < 2; ++ex)
#pragma unroll
                for (int r = 0; r < 16; ++r) { o[ex][0][r] = 0.f; o[ex][1][r] = 0.f; }
#pragma unroll
            for (int dt = 0; dt < 4; ++dt)
#pragma unroll
                for (int s = 0; s < 2; ++s) {
                    bf16x8 af[2];
#pragma unroll
                    for (int it = 0; it < 2; ++it) { const LAS unsigned char* p = r_qi + it * (32 * QS) + dt * 64 + s * 32; af[it] = cat8(*(const LAS s16x4*)(p), *(const LAS s16x4*)(p + 16)); }
#pragma unroll
                    for (int ex = 0; ex < 2; ++ex) {
                        u32x4 bw; bw.x = pk2(S[ex][dt][8 * s + 0], S[ex][dt][8 * s + 1]); bw.y = pk2(S[ex][dt][8 * s + 2], S[ex][dt][8 * s + 3]);
                        bw.z = pk2(S[ex][dt][8 * s + 4], S[ex][dt][8 * s + 5]); bw.w = pk2(S[ex][dt][8 * s + 6], S[ex][dt][8 * s + 7]);
                        const bf16x8 bfr = __builtin_bit_cast(bf16x8, bw);
#pragma unroll
                        for (int it = 0; it < 2; ++it) o[ex][it] = MFMA32(af[it], bfr, o[ex][it]);
                    }
                }
            LBAR();
#pragma unroll
            for (int ex = 0; ex < 2; ++ex) {
#pragma unroll
                for (int ks = 0; ks < 4; ++ks) {
                    const bf16x8 bv = cat8(tr_read(vb0 + ex * 512 + v_rd_off(0, ks, 0)), tr_read(vb0 + ex * 512 + v_rd_off(0, ks, 1)));
#pragma unroll
                    for (int it = 0; it < 2; ++it) o[ex][it] = MFMA32(*(const LAS bf16x8*)(r_st + it * (32 * SS) + ks * 32), bv, o[ex][it]);
                }
#pragma unroll
                for (int it = 0; it < 2; ++it)
#pragma unroll
                    for (int r = 0; r < 16; ++r) *(LAS bf16_t*)(w_o + ex * 64 + (32 * it + (r & 3) + 8 * (r >> 2)) * 512) = (bf16_t)(pk2(o[ex][it][r], 0.f) & 0xffffu);
            }
            LBAR();
            {
                bf16x8 Bv[2][4];
#pragma unroll
                for (int ex = 0; ex < 2; ++ex)
#pragma unroll
                    for (int ks = 0; ks < 4; ++ks) Bv[ex][ks] = cat8(tr_read(vb0 + ex * 512 + v_rd_off(0, ks, 0)), tr_read(vb0 + ex * 512 + v_rd_off(0, ks, 1)));
#pragma unroll
                for (int dt = 0; dt < 4; ++dt) {
                    bf16x8 kf[4];
#pragma unroll
                    for (int ks = 0; ks < 4; ++ks) kf[ks] = cat8(tr_read(kdbase + v_rd_off(dt, ks, 0)), tr_read(kdbase + v_rd_off(dt, ks, 1)));
#pragma unroll
                    for (int g4 = 0; g4 < 4; ++g4) {
                        const f32x4 dc = *(const LAS f32x4*)(r_dec + parM + dt * 128 + g4 * 32);
#pragma unroll
                        for (int x = 0; x < 4; ++x) { S[0][dt][4 * g4 + x] *= dc[x]; S[1][dt][4 * g4 + x] *= dc[x]; }
                    }
#pragma unroll
                    for (int ex = 0; ex < 2; ++ex)
#pragma unroll
                        for (int ks = 0; ks < 4; ++ks) S[ex][dt] = MFMA32(kf[ks], Bv[ex][ks], S[ex][dt]);
                }
            }
            if (n < 0) {
#pragma unroll
                for (int ex = 0; ex < 2; ++ex)
#pragma unroll
                    for (int i = 0; i < 4; ++i)
#pragma unroll
                        for (int r = 0; r < 16; ++r) S[ex][i][r] = 0.f;
            }
            LBAR();
        }
    } else {
        const int w4 = wid - 4, ptid = tid - 256;
        const int gd = w4 * 32 + r32;
        const float* wg = dir ? X.wgb : X.wgf; const float* bg = dir ? X.bgb : X.bgf;
        bf16x8 Bhi, Blo;
        {
            float wv[8]; unsigned whi[4], wlo[4];
#pragma unroll
            for (int jj = 0; jj < 8; ++jj) wv[jj] = wg[(8 * hi + jj) * 512 + h * DK + gd];
#pragma unroll
            for (int p = 0; p < 4; ++p) { whi[p] = pk2(wv[2 * p], wv[2 * p + 1]); wlo[p] = pk2(wv[2 * p] - bflo(whi[p]), wv[2 * p + 1] - bfhi(whi[p])); }
            Bhi = __builtin_bit_cast(bf16x8, (u32x4){whi[0], whi[1], whi[2], whi[3]}); Blo = __builtin_bit_cast(bf16x8, (u32x4){wlo[0], wlo[1], wlo[2], wlo[3]});
        }
        const float bias = bg[h * DK + gd];
        u32x4 qreg[4], kreg[4], vreg[8]; f32x4 lrreg[2][2];
        const int qj0 = ptid >> 4, qo = ptid & 15;
        const int prow = ptid >> 4, pc = (ptid & 15) * 16;
        const unsigned lo_qk = (unsigned)(qj0 * 512 + qo * 8), lo_v = (unsigned)(qj0 * D + qo * 8), lo_lr = (unsigned)(r32 * 32 + 8 * hi);
#define GLA_CHUNK_PTRS(step_) const int s_ = (step_); const bf16_t *qp_, *kp_, *vp_; const float* lp_; \
        if (dir == 0 && s_ == 0) { qp_ = X.Kmeta + h * DK; kp_ = qp_; vp_ = X.Vmeta + h * DV; lp_ = X.LRmeta; } \
        else { const int c_ = dir ? (31 - s_) : (s_ - 1); const size_t rb_ = (size_t)b * T + (size_t)c_ * CH; \
               qp_ = X.Q + rb_ * 512 + h * DK; kp_ = X.K + rb_ * 512 + h * DK; vp_ = X.V + rb_ * D + h * DV; lp_ = X.LR + rb_ * 32 + dir * 16; } \
        (void)qp_; (void)kp_; (void)vp_; (void)lp_;
#define GLA_LOAD_QK(step_) do { GLA_CHUNK_PTRS(step_) _Pragma("unroll") for (int it = 0; it < 4; ++it) { qreg[it] = *(const u32x4*)((qp_ + it * 16 * 512) + lo_qk); kreg[it] = *(const u32x4*)((kp_ + it * 16 * 512) + lo_qk); } } while (0)
#define GLA_LOAD_V(step_) do { GLA_CHUNK_PTRS(step_) _Pragma("unroll") for (int itr = 0; itr < 4; ++itr) _Pragma("unroll") for (int itp = 0; itp < 2; ++itp) vreg[itr * 2 + itp] = *(const u32x4*)((vp_ + (16 * itr) * D + itp * 128) + lo_v); } while (0)
#define GLA_STORE_V() do { _Pragma("unroll") for (int itr = 0; itr < 4; ++itr) _Pragma("unroll") for (int itp = 0; itp < 2; ++itp) *(LAS u32x4*)(w_v + itr * 4096 + itp * 16384) = vreg[itr * 2 + itp]; } while (0)
#define GLA_LOAD_LR(step_) do { GLA_CHUNK_PTRS(step_) _Pragma("unroll") for (int tj = 0; tj < 2; ++tj) { lrreg[tj][0] = *(const f32x4*)((lp_ + tj * 32 * 32) + lo_lr); lrreg[tj][1] = *(const f32x4*)((lp_ + tj * 32 * 32 + 4) + lo_lr); } } while (0)
#define GLA_CLAMP(s_) ((s_) < nsteps ? (s_) : nsteps - 1)
        GLA_LOAD_LR(0);
        LAS unsigned char* const w_e = lds + L_E + ((4 * hi) * 128 + gd) * 4;
        const LAS unsigned char* const r_e = lds + L_E + (qj0 * 128 + qo * 8) * 4;
        const LAS unsigned char* const r_dc = lds + L_DEC + qo * 32;
        LAS unsigned char* const w_qi = lds + L_QI + qj0 * QS + qo * 16;
        LAS unsigned char* const w_kd = lds + L_KD + v_st(qj0, qo * 8);
        LAS unsigned char* const w_v = lds + L_V + v_st(qj0, qo * 8);
        const LAS unsigned char* const r_o = lds + L_O + prow * 512 + pc * 2;
        const LAS unsigned char* const r_gn = lds + L_GN + pc * 4;
        unsigned kd[4][4];
#pragma unroll
        for (int it = 0; it < 4; ++it)
#pragma unroll
            for (int p = 0; p < 4; ++p) kd[it][p] = 0u;
        for (int n = -1; n < nsteps; ++n) {
            if (n == nmid) xcd_barrier(xbar);
            const bool second = n >= nmid;
            const int parP = ((n + 1) & 1) * 512;
            if (n >= 0) {
#pragma unroll
                for (int it = 0; it < 4; ++it) *(LAS u32x4*)(w_kd + it * 4096) = (u32x4){kd[it][0], kd[it][1], kd[it][2], kd[it][3]};
            }
            GLA_LOAD_QK(GLA_CLAMP(n + 1));
            {
                float base = 0.f;
#define GLA_GATE_TILE(tj) do { \
                    const f32x4 l0 = lrreg[tj][0], l1 = lrreg[tj][1]; \
                    unsigned ah[4], al[4]; \
                    ah[0] = pk2(l0[0], l0[1]); ah[1] = pk2(l0[2], l0[3]); ah[2] = pk2(l1[0], l1[1]); ah[3] = pk2(l1[2], l1[3]); \
                    al[0] = pk2(l0[0] - bflo(ah[0]), l0[1] - bfhi(ah[0])); al[1] = pk2(l0[2] - bflo(ah[1]), l0[3] - bfhi(ah[1])); \
                    al[2] = pk2(l1[0] - bflo(ah[2]), l1[1] - bfhi(ah[2])); al[3] = pk2(l1[2] - bflo(ah[3]), l1[3] - bfhi(ah[3])); \
                    const bf16x8 Ahi = __builtin_bit_cast(bf16x8, (u32x4){ah[0], ah[1], ah[2], ah[3]}), Alo = __builtin_bit_cast(bf16x8, (u32x4){al[0], al[1], al[2], al[3]}); \
                    f32x16 z; \
                    _Pragma("unroll") for (int r = 0; r < 16; ++r) z[r] = 0.f; \
                    z = MFMA32(Ahi, Bhi, z); z = MFMA32(Ahi, Blo, z); z = MFMA32(Alo, Bhi, z); \
                    float e[16], G[4], PG[4]; \
                    _Pragma("unroll") for (int g4 = 0; g4 < 4; ++g4) { \
                        float gv[4]; \
                        _Pragma("unroll") for (int x = 0; x < 4; ++x) { const float zz = z[4 * g4 + x] + bias; \
                            gv[x] = (fminf(zz, 0.f) - 0.6931471805599453f * __builtin_amdgcn_logf(1.f + __builtin_amdgcn_exp2f(-1.4426950408889634f * fabsf(zz)))) * 0.0625f; } \
                        if (dir == 0) { e[4 * g4] = gv[0]; e[4 * g4 + 1] = gv[0] + gv[1]; e[4 * g4 + 2] = e[4 * g4 + 1] + gv[2]; e[4 * g4 + 3] = e[4 * g4 + 2] + gv[3]; G[g4] = e[4 * g4 + 3]; } \
                        else          { e[4 * g4 + 3] = gv[3]; e[4 * g4 + 2] = gv[3] + gv[2]; e[4 * g4 + 1] = e[4 * g4 + 2] + gv[1]; e[4 * g4] = e[4 * g4 + 1] + gv[0]; G[g4] = e[4 * g4]; } \
                        PG[g4] = __shfl_xor(G[g4], 32); \
                    } \
                    float pre[4], run = base; \
                    if (dir == 0) { _Pragma("unroll") for (int g4 = 0; g4 < 4; ++g4) { pre[g4] = run + (hi ? PG[g4] : 0.f); run += G[g4] + PG[g4]; } } \
                    else          { _Pragma("unroll") for (int g4 = 3; g4 >= 0; --g4) { pre[g4] = run + (hi ? 0.f : PG[g4]); run += G[g4] + PG[g4]; } } \
                    base = run; \
                    _Pragma("unroll") for (int r = 0; r < 16; ++r) *(LAS float*)(w_e + (32 * (tj) + 8 * (r >> 2) + (r & 3)) * 512) = (e[r] + pre[r >> 2]) * 1.4426950408889634f; \
                } while (0)
                if (dir == 0) { GLA_GATE_TILE(0); GLA_GATE_TILE(1); } else { GLA_GATE_TILE(1); GLA_GATE_TILE(0); }
#undef GLA_GATE_TILE
                if (hi == 0) *(LAS float*)(lds + L_DEC + parP + gd * 4) = __builtin_amdgcn_exp2f(1.4426950408889634f * base);
            }
            if (n >= 0) GLA_STORE_V();

            LBAR();
            GLA_LOAD_LR(GLA_CLAMP(n + 2));
#pragma unroll
            for (int it = 0; it < 4; ++it) {
                const f32x4 e0 = *(const LAS f32x4*)(r_e + it * 8192), e1 = *(const LAS f32x4*)(r_e + it * 8192 + 16);
                const f32x4 t0 = *(const LAS f32x4*)(r_dc + parP), t1 = *(const LAS f32x4*)(r_dc + parP + 16);
                const float ev[8] = {e0[0], e0[1], e0[2], e0[3], e1[0], e1[1], e1[2], e1[3]}, tv[8] = {t0[0], t0[1], t0[2], t0[3], t1[0], t1[1], t1[2], t1[3]};
                const unsigned qw[4] = {qreg[it].x, qreg[it].y, qreg[it].z, qreg[it].w}, kw[4] = {kreg[it].x, kreg[it].y, kreg[it].z, kreg[it].w};
                unsigned qi[4], ki[4];
#pragma unroll
                for (int p = 0; p < 4; ++p) {
                    const float q0 = bflo(qw[p]), q1 = bfhi(qw[p]);
                    const float k0 = bflo(kw[p]) * __builtin_amdgcn_exp2f(-ev[2 * p]), k1 = bfhi(kw[p]) * __builtin_amdgcn_exp2f(-ev[2 * p + 1]);
                    qi[p] = pk2(q0 * __builtin_amdgcn_exp2f(ev[2 * p]), q1 * __builtin_amdgcn_exp2f(ev[2 * p + 1]));
                    ki[p] = pk2(k0, k1);
                    kd[it][p] = pk2(k0 * tv[2 * p], k1 * tv[2 * p + 1]);
                }
                *(LAS u32x4*)(w_qi + it * 16 * QS) = (u32x4){qi[0], qi[1], qi[2], qi[3]};
                *(LAS u32x4*)(w_qi + (L_KI - L_QI) + it * 16 * QS) = (u32x4){ki[0], ki[1], ki[2], ki[3]};
                __builtin_amdgcn_sched_barrier(0);
            }
            if (!second) {
                LBAR();
                if (n >= 0 && !(dir == 0 && n == 0)) {
                    const int c = dir ? (31 - n) : (n - 1);
                    bf16_t* ob_ = (dir ? X.OB : X.OF) + ((size_t)b * T + (size_t)c * CH) * D + h * DV;
                    const unsigned lo_o = (unsigned)(prow * D + pc);
#pragma unroll
                    for (int sub = 0; sub < 4; ++sub) {
                        const u32x4 a0 = *(const LAS u32x4*)(r_o + sub * (16 * 512)), a1 = *(const LAS u32x4*)(r_o + sub * (16 * 512) + 16);
                        bf16_t* po_ = ob_ + (lo_o + (unsigned)(16 * sub * D));
                        *(u32x4*)(po_) = a0; *(u32x4*)(po_ + 8) = a1;
                    }
                }
            } else {
                u32x4 oo[2][2], rr4[2][2];
                const int c = dir ? (31 - n) : (n - 1);
                const bf16_t* ob_ = (dir ? X.OF : X.OB) + ((size_t)b * T + (size_t)c * CH) * D + h * DV;
                bf16_t* rb2_ = X.A2 + ((size_t)b * T + (size_t)c * CH) * (2 * D) + D + h * DV;
                const unsigned lo_o = (unsigned)(prow * D + pc), lo_r = (unsigned)(prow * (2 * D) + pc);
#define GLA_ROWLOAD(slot_, sub_) do { const bf16_t* po_ = ob_ + (lo_o + (unsigned)(16 * (sub_) * D)); const bf16_t* pr_ = rb2_ + (lo_r + (unsigned)(16 * (sub_) * 2 * D)); \
                    oo[slot_][0] = *(const u32x4*)(po_); oo[slot_][1] = *(const u32x4*)(po_ + 8); rr4[slot_][0] = *(const u32x4*)(pr_); rr4[slot_][1] = *(const u32x4*)(pr_ + 8); } while (0)
                GLA_ROWLOAD(0, 0); GLA_ROWLOAD(1, 1);
                LBAR();
#pragma unroll
                for (int sub = 0; sub < 4; ++sub) {
                    bf16_t* py = rb2_ + (lo_r + (unsigned)(16 * sub * 2 * D));
                    float v[16]; float ss = 0.f;
#pragma unroll
                    for (int q = 0; q < 2; ++q) {
                        const u32x4 mine = *(const LAS u32x4*)(r_o + sub * (16 * 512) + 16 * q), oth = oo[sub & 1][q];
                        v[8 * q + 0] = bflo(mine.x) + bflo(oth.x); v[8 * q + 1] = bfhi(mine.x) + bfhi(oth.x); v[8 * q + 2] = bflo(mine.y) + bflo(oth.y); v[8 * q + 3] = bfhi(mine.y) + bfhi(oth.y);
                        v[8 * q + 4] = bflo(mine.z) + bflo(oth.z); v[8 * q + 5] = bfhi(mine.z) + bfhi(oth.z); v[8 * q + 6] = bflo(mine.w) + bflo(oth.w); v[8 * q + 7] = bfhi(mine.w) + bfhi(oth.w);
                    }
                    const u32x4 rw0 = rr4[sub & 1][0], rw1 = rr4[sub & 1][1];
                    if (sub < 2) GLA_ROWLOAD(sub & 1, sub + 2);
#pragma unroll
                    for (int e2 = 0; e2 < 16; ++e2) ss += v[e2] * v[e2];
                    ss += __shfl_xor(ss, 1); ss += __shfl_xor(ss, 2); ss += __shfl_xor(ss, 4); ss += __shfl_xor(ss, 8);
                    const float rstd = 1.0f / sqrtf(ss * (1.f / DV) + EPS);
#pragma unroll
                    for (int q = 0; q < 2; ++q) {
                        const f32x4 g0 = *(const LAS f32x4*)(r_gn + 32 * q), g1 = *(const LAS f32x4*)(r_gn + 32 * q + 16);
                        const u32x4 rw = q ? rw1 : rw0;
                        const float rv[8] = {bflo(rw.x), bfhi(rw.x), bflo(rw.y), bfhi(rw.y), bflo(rw.z), bfhi(rw.z), bflo(rw.w), bfhi(rw.w)};
                        const float gg[8] = {g0[0], g0[1], g0[2], g0[3], g1[0], g1[1], g1[2], g1[3]};
                        float zz[8];
#pragma unroll
                        for (int e2 = 0; e2 < 8; ++e2) zz[e2] = v[8 * q + e2] * rstd * gg[e2] * rv[e2] * sigm(rv[e2]);
                        *(u32x4*)(py + 8 * q) = (u32x4){pk2(zz[0], zz[1]), pk2(zz[2], zz[3]), pk2(zz[4], zz[5]), pk2(zz[6], zz[7])};
                    }
                }
#undef GLA_ROWLOAD
            }
            GLA_LOAD_V(GLA_CLAMP(n + 1));
            LBAR();
        }
#undef GLA_CHUNK_PTRS
#undef GLA_LOAD_QK
#undef GLA_LOAD_V
#undef GLA_STORE_V
#undef GLA_LOAD_LR
#undef GLA_CLAMP
    }
}
}

constexpr int NWAVES = 8, LDS_BYTES = 162304, MISC_OFF = 162048, CONV_STG = 131072, CONV_STG_WAVE = 2304;
constexpr size_t WS_CTL = 0, CTL_BYTES = 16384;
struct Args { const float* in[14]; float* out; unsigned char* ws; int ph_lo, ph_hi; };
struct Frame {
    LAS unsigned char* lds; int tid, lane, wave, G, vcu;
    const float *x, *meta, *g_pre, *w_in, *conv_w, *wgf, *bgf, *wgb, *bgb, *gn, *w_oc, *w_og, *w_mo, *g_post;
    float* out; unsigned char* ws;
};
__device__ __forceinline__ int deal_row(int k, int gw, int NGW) { return k * NGW + ((gw + 488 * k) & (NGW - 1)); }
__device__ __forceinline__ float wave_sum(float v) {
#pragma unroll
    for (int o = 1; o < 64; o <<= 1) v += __shfl_xor(v, o);
    return v;
}
__device__ __forceinline__ int win_src_col(int r) {
    const int pn = r >> 8, s = r & 255, bj = s >> 7, wc = (s >> 5) & 3, n = (s >> 4) & 1, fq = (s >> 2) & 3, e = s & 3;
    if (pn < 16) return (2 * bj + n) * 1024 + pn * 64 + wc * 16 + fq * 4 + e;
    const int oc = 128 * bj + 32 * wc + 8 * fq + 4 * n + e;
    if (pn < 18) return O_Q + (pn - 16) * 256 + oc;
    if (pn < 20) return O_K + (pn - 18) * 256 + oc;
    if (pn < 24) return O_V + (pn - 20) * 256 + oc;
    if (pn < 28) return O_R + (pn - 24) * 256 + oc;
    if (pn < 36) return (bj ? O_MB : O_MA) + (pn - 28) * 128 + 32 * wc + 8 * fq + 4 * n + e;
    return s < 32 ? O_LRF + s : -1;
}
__device__ __forceinline__ int perm_col(int r) {
    const int pn = r >> 8, s = r & 255, bj = s >> 7, wc = (s >> 5) & 3, n = (s >> 4) & 1, fq = (s >> 2) & 3, e = s & 3;
    return pn * 256 + 128 * bj + 32 * wc + 8 * fq + 4 * n + e;
}
template <class SrcFn> __device__ __forceinline__ void transpose_item(SrcFn src, bf16_t* Wt, int Kd, int r0, int k0, LAS float* scr, int lane) {
    float tv[32];
#pragma unroll
    for (int i = 0; i < 32; ++i) tv[i] = src(k0 + 2 * i + (lane >> 5), r0 + (lane & 31));
#pragma unroll
    for (int i = 0; i < 32; ++i) scr[(2 * i + (lane >> 5)) * 33 + (lane & 31)] = tv[i];
    LDS_WAIT(); asm volatile("" ::: "memory");
    const int c = lane & 7;
#pragma unroll
    for (int j = 0; j < 4; ++j) { const int n = (lane >> 3) + 8 * j; const LAS float* s = scr + (8 * c) * 33 + n;
        u32x4 o; o.x = pk2(s[0 * 33], s[1 * 33]); o.y = pk2(s[2 * 33], s[3 * 33]); o.z = pk2(s[4 * 33], s[5 * 33]); o.w = pk2(s[6 * 33], s[7 * 33]);
        *(u32x4*)(Wt + (size_t)(r0 + n) * Kd + k0 + 8 * c) = o; }
    LDS_WAIT(); asm volatile("" ::: "memory");
}
constexpr int META_JOBS = 57, META_KQ = 4, META_ITEMS = META_JOBS * META_KQ, META_COLS = META_JOBS * 64;
constexpr size_t WS_MPART = 48 * MiB;
__device__ __forceinline__ void p0_meta(Frame& F, int item) {
    const int job = item >> 2, kq = item & 3;
    LAS float* umT = (LAS float*)F.lds;
    LAS float* red = (LAS float*)(F.lds + 65536);
    for (int rr = 0; rr < 2; ++rr) {
        const int j = 2 * F.wave + rr; const float* mr = F.meta + (size_t)j * D;
        f32x4 v[4]; float s = 0.f;
#pragma unroll
        for (int q = 0; q < 4; ++q) { v[q] = *(const f32x4*)(mr + 4 * F.lane + 256 * q); s += (v[q][0] * v[q][0] + v[q][1] * v[q][1]) + (v[q][2] * v[q][2] + v[q][3] * v[q][3]); }
        const float rstd = 1.0f / sqrtf(wave_sum(s) * (1.f / D) + EPS);
#pragma unroll
        for (int q = 0; q < 4; ++q)
#pragma unroll
            for (int e = 0; e < 4; ++e) { const int col = 4 * F.lane + 256 * q + e; umT[col * 16 + j] = v[q][e] * rstd * F.g_pre[col]; }
    }
    __syncthreads();
    const int ci = job * 64 + F.lane;
    const bool valid = ci < 3600;
    const int src = ci < 2048 ? (O_CC + ci) : (ci < 3584 ? (O_K + (ci - 2048)) : (valid ? O_LRF + (ci - 3584) : 0));
    float acc[16];
#pragma unroll
    for (int j = 0; j < 16; ++j) acc[j] = 0.f;
    const int kbase = kq * 256 + F.wave * 32;
    const float* wp = F.w_in + src + (size_t)kbase * NIN;
    const LAS float* up = umT + kbase * 16;
#pragma unroll 1
    for (int k0 = 0; k0 < 32; k0 += 16) {
        float w[16];
#pragma unroll
        for (int i = 0; i < 16; ++i) w[i] = wp[(size_t)(k0 + i) * NIN];
#pragma unroll
        for (int i = 0; i < 16; ++i) {
            const LAS f32x4* u4 = (const LAS f32x4*)(up + (k0 + i) * 16);
#pragma unroll
            for (int q = 0; q < 4; ++q) { const f32x4 u = u4[q]; acc[4 * q] += w[i] * u[0]; acc[4 * q + 1] += w[i] * u[1]; acc[4 * q + 2] += w[i] * u[2]; acc[4 * q + 3] += w[i] * u[3]; }
            if ((i & 1) == 1) __builtin_amdgcn_sched_barrier(0);
        }
    }
#pragma unroll
    for (int j = 0; j < 16; ++j) red[(F.wave * 16 + j) * 64 + F.lane] = acc[j];
    __syncthreads();
    float* part = (float*)(F.ws + WS_MPART) + (size_t)kq * 16 * META_COLS;
    for (int o = F.tid; o < 1024; o += NWAVES * 64) {
        const int j = o >> 6, c = o & 63;
        float s = 0.f;
#pragma unroll
        for (int w = 0; w < 8; ++w) s += red[(w * 16 + j) * 64 + c];
        part[j * META_COLS + job * 64 + c] = s;
    }
    __syncthreads();
}
__device__ __forceinline__ void meta_reduce(Frame& F, int job) {
    const float* part = (const float*)(F.ws + WS_MPART);
    unsigned char* mb = F.ws + WS_META;
    bf16_t* kmeta = (bf16_t*)(mb + META_K); bf16_t* vmeta = (bf16_t*)(mb + META_V); float* lrm = (float*)(mb + META_LR);
    for (int o = F.tid; o < 1024; o += NWAVES * 64) {
        const int j = o >> 6, c = o & 63, cj = job * 64 + c;
        float s = 0.f;
#pragma unroll
        for (int q = 0; q < META_KQ; ++q) s += part[((size_t)q * 16 + j) * META_COLS + cj];
        if (cj < 1024) { if (j == 15) ((float*)(mb + META_CC))[cj] = s; }
        else if (cj < 2048) { if (j == 15) ((float*)(mb + META_CX))[cj - 1024] = s; }
        else if (cj < 2560) kmeta[(48 + j) * 512 + (cj - 2048)] = (bf16_t)(pk2(s, 0.f) & 0xffffu);
        else if (cj < 3584) vmeta[(48 + j) * 1024 + (cj - 2560)] = (bf16_t)(pk2(s, 0.f) & 0xffffu);
        else if (cj < 3600) { lrm[(48 + j) * 32 + (cj - 3584)] = s; lrm[(48 + j) * 32 + 16 + (cj - 3584)] = 0.f; }
    }
    for (int o = F.tid; o < 48 * 64; o += NWAVES * 64) {
        const int j = o >> 6, cj = job * 64 + (o & 63);
        if (cj >= 2048 && cj < 2560) kmeta[j * 512 + (cj - 2048)] = 0;
        else if (cj >= 2560 && cj < 3584) vmeta[j * 1024 + (cj - 2560)] = 0;
        else if (cj >= 3584 && cj < 3600) { lrm[j * 32 + (cj - 3584)] = 0.f; lrm[j * 32 + 16 + (cj - 3584)] = 0.f; }
    }
}
__device__ __forceinline__ void p0_prologue(Frame& F) {
    if (blockIdx.x < META_ITEMS) p0_meta(F, (int)blockIdx.x);
    LAS float* scr = (LAS float*)(F.lds + F.wave * 16384);
    const int gw = F.vcu * NWAVES + F.wave, NGW = F.G * NWAVES;
    bf16_t* Wt_in = (bf16_t*)(F.ws + WS_WIN); bf16_t* Wt_mg = (bf16_t*)(F.ws + WS_WMG); bf16_t* Wt_out = (bf16_t*)(F.ws + WS_WOUT);
    constexpr int I_IN = (NSLOT / 32) * (D / 64), I_MG = (D / 32) * (2 * D / 64), I_OUT = (D / 32) * (D / 64);
    const float* w_in = F.w_in; const float* w_oc = F.w_oc; const float* w_og = F.w_og; const float* w_mo = F.w_mo;
    for (int it = gw; it < I_IN + I_MG + I_OUT; it += NGW) {
        int r = it;
        if (r < I_IN) { const int rb = r / (D / 64), kb = r % (D / 64);
            transpose_item([=](int k, int row) { const int c = win_src_col(row); return c < 0 ? 0.f : w_in[(size_t)k * NIN + c]; }, Wt_in, D, rb * 32, kb * 64, scr, F.lane); continue; }
        r -= I_IN;
        if (r < I_MG) { const int rb = r / (2 * D / 64), kb = r % (2 * D / 64);
            transpose_item([=](int k, int row) { const int c = perm_col(row); return k < D ? w_oc[(size_t)k * D + c] : w_og[(size_t)(k - D) * D + c]; }, Wt_mg, 2 * D, rb * 32, kb * 64, scr, F.lane); continue; }
        r -= I_MG;
        { const int rb = r / (D / 64), kb = r % (D / 64);
            transpose_item([=](int k, int row) { return w_mo[(size_t)k * D + perm_col(row)]; }, Wt_out, D, rb * 32, kb * 64, scr, F.lane); }
    }
    bf16_t* U = (bf16_t*)(F.ws + WS_U); float* rmsx = (float*)(F.ws + WS_RMS);
    f32x4 gp[4];
#pragma unroll
    for (int q = 0; q < 4; ++q) gp[q] = *(const f32x4*)(F.g_pre + 4 * F.lane + 256 * q);
    for (int k = 0; k < M / NGW; k += 2) {
        const int m = deal_row(k, gw, NGW), m2 = deal_row(k + 1, gw, NGW);
        const float* xr = F.x + (size_t)m * D + 4 * F.lane; const float* xr2 = F.x + (size_t)m2 * D + 4 * F.lane;
        f32x4 v[4], w[4]; float s = 0.f, s2 = 0.f;
#pragma unroll
        for (int q = 0; q < 4; ++q) { v[q] = __builtin_nontemporal_load((const f32x4*)(xr + 256 * q)); w[q] = __builtin_nontemporal_load((const f32x4*)(xr2 + 256 * q)); }
#pragma unroll
        for (int q = 0; q < 4; ++q) { s += (v[q][0] * v[q][0] + v[q][1] * v[q][1]) + (v[q][2] * v[q][2] + v[q][3] * v[q][3]); s2 += (w[q][0] * w[q][0] + w[q][1] * w[q][1]) + (w[q][2] * w[q][2] + w[q][3] * w[q][3]); }
        const float ms = wave_sum(s) * (1.f / D) + EPS, ms2 = wave_sum(s2) * (1.f / D) + EPS;
        const float rstd = 1.0f / sqrtf(ms), rstd2 = 1.0f / sqrtf(ms2);
        if (F.lane == 0) { rmsx[m] = sqrtf(ms); rmsx[m2] = sqrtf(ms2); }
        bf16_t* ur = U + (size_t)m * D + 4 * F.lane; bf16_t* ur2 = U + (size_t)m2 * D + 4 * F.lane;
#pragma unroll
        for (int q = 0; q < 4; ++q) { const f32x4 y = v[q] * rstd * gp[q], y2 = w[q] * rstd2 * gp[q];
            *(u32x2*)(ur + 256 * q) = (u32x2){pk2(y[0], y[1]), pk2(y[2], y[3])}; *(u32x2*)(ur2 + 256 * q) = (u32x2){pk2(y2[0], y2[1]), pk2(y2[2], y2[3])}; }
    }
}
__device__ __forceinline__ void conv_fixup(Frame& F) {
    const int gw = F.vcu * NWAVES + F.wave, NGW = F.G * NWAVES;
    const bf16_t* SP = (const bf16_t*)(F.ws + WS_SIDEP); const bf16_t* SG = (const bf16_t*)(F.ws + WS_SIDEG); bf16_t* A2 = (bf16_t*)(F.ws + WS_A2);
    const float* cc15 = (const float*)(F.ws + WS_META + META_CC); const float* cx15 = (const float*)(F.ws + WS_META + META_CX);
    for (int i = gw; i < M / 32; i += NGW) {
        const int run = i >> 1; const bool first = (i & 1) == 0;
        const int t = run * 64 + (first ? 0 : 63), tl = t & (T - 1);
#pragma unroll
        for (int half = 0; half < 2; ++half) {
            const int c0 = half * 512 + 8 * F.lane;
            const u32x4 yq = *(const u32x4*)(A2 + (size_t)t * (2 * D) + c0);
            const u32x4 gq = *(const u32x4*)(SG + ((size_t)run * 2 + (first ? 0 : 1)) * D + c0);
            float pn_[8];
            if (first ? (tl != 0) : (tl != T - 1)) {
                const u32x4 w = *(const u32x4*)(SP + ((size_t)(first ? run - 1 : run + 1) * 2 + (first ? 1 : 0)) * D + c0);
                pn_[0] = bflo(w.x); pn_[1] = bfhi(w.x); pn_[2] = bflo(w.y); pn_[3] = bfhi(w.y); pn_[4] = bflo(w.z); pn_[5] = bfhi(w.z); pn_[6] = bflo(w.w); pn_[7] = bfhi(w.w);
            } else {
#pragma unroll
                for (int e = 0; e < 8; ++e) pn_[e] = first ? cc15[c0 + e] * cx15[c0 + e] : 0.f;
            }
            const float yv[8] = {bflo(yq.x), bfhi(yq.x), bflo(yq.y), bfhi(yq.y), bflo(yq.z), bfhi(yq.z), bflo(yq.w), bfhi(yq.w)};
            const float gg[8] = {bflo(gq.x), bfhi(gq.x), bflo(gq.y), bfhi(gq.y), bflo(gq.z), bfhi(gq.z), bflo(gq.w), bfhi(gq.w)};
            float y[8];
#pragma unroll
            for (int e = 0; e < 8; ++e) y[e] = yv[e] + gg[e] * F.conv_w[(first ? 0 : 2 * D) + c0 + e] * pn_[e];
            *(u32x4*)(A2 + (size_t)t * (2 * D) + c0) = (u32x4){pk2(y[0], y[1]), pk2(y[2], y[3]), pk2(y[4], y[5]), pk2(y[6], y[7])};
        }
    }
}
__device__ __forceinline__ void p6_final(Frame& F) {
    const int gw = F.vcu * NWAVES + F.wave, NGW = F.G * NWAVES;
    const float* stats = (const float*)(F.ws + WS_STATS); const bf16_t* raw = (const bf16_t*)(F.ws + WS_RAW);
    const bf16_t* U = (const bf16_t*)(F.ws + WS_U); const float* rmsx = (const float*)(F.ws + WS_RMS);
    f32x4 gp[4], gi[4];
#pragma unroll
    for (int q = 0; q < 4; ++q) { gp[q] = *(const f32x4*)(F.g_post + 8 * F.lane + 512 * (q >> 1) + 4 * (q & 1)); const f32x4 g = *(const f32x4*)(F.g_pre + 8 * F.lane + 512 * (q >> 1) + 4 * (q & 1));
        gi[q] = (f32x4){1.f / g[0], 1.f / g[1], 1.f / g[2], 1.f / g[3]}; }
    for (int k = 0; k < M / NGW; ++k) {
        const int m = deal_row(k, gw, NGW);
        const f32x4 s0 = *(const f32x4*)(stats + (size_t)m * 16), s1 = *(const f32x4*)(stats + (size_t)m * 16 + 4), s2 = *(const f32x4*)(stats + (size_t)m * 16 + 8), s3 = *(const f32x4*)(stats + (size_t)m * 16 + 12);
        const float ss = ((s0[0] + s0[1]) + (s0[2] + s0[3])) + ((s1[0] + s1[1]) + (s1[2] + s1[3])) + ((s2[0] + s2[1]) + (s2[2] + s2[3])) + ((s3[0] + s3[1]) + (s3[2] + s3[3]));
        const float rstd = 1.0f / sqrtf(ss * (1.f / D) + EPS), rx = rmsx[m];
        float* orow = F.out + (size_t)m * D + 8 * F.lane; const bf16_t* rr = raw + (size_t)m * D + 8 * F.lane; const bf16_t* ur = U + (size_t)m * D + 8 * F.lane;
#pragma unroll
        for (int hf = 0; hf < 2; ++hf) {
            const u32x4 rw = __builtin_nontemporal_load((const u32x4*)(rr + 512 * hf)), uw = __builtin_nontemporal_load((const u32x4*)(ur + 512 * hf));
            const f32x4 r0 = {bflo(rw.x), bfhi(rw.x), bflo(rw.y), bfhi(rw.y)}, r1 = {bflo(rw.z), bfhi(rw.z), bflo(rw.w), bfhi(rw.w)};
            const f32x4 x0 = (f32x4){bflo(uw.x), bfhi(uw.x), bflo(uw.y), bfhi(uw.y)} * gi[2 * hf] * rx, x1 = (f32x4){bflo(uw.z), bfhi(uw.z), bflo(uw.w), bfhi(uw.w)} * gi[2 * hf + 1] * rx;
            __builtin_nontemporal_store(x0 + r0 * rstd * gp[2 * hf], (f32x4*)(orow + 512 * hf)); __builtin_nontemporal_store(x1 + r1 * rstd * gp[2 * hf + 1], (f32x4*)(orow + 512 * hf + 4));
        }
    }
}

__global__ void __launch_bounds__(NWAVES * 64, 2) fwd_kernel(Args args) {
    extern __shared__ __attribute__((aligned(16))) unsigned char lds_raw[];
    Frame F;
    F.lds = (LAS unsigned char*)lds_raw;
    F.tid = threadIdx.x; F.lane = F.tid & 63; F.wave = __builtin_amdgcn_readfirstlane(F.tid >> 6);
    F.G = gridDim.x; { const int bx = blockIdx.x; F.vcu = (F.G % 8 == 0) ? (bx % 8) * (F.G / 8) + bx / 8 : bx; }
    F.x = args.in[0]; F.meta = args.in[1]; F.g_pre = args.in[2]; F.w_in = args.in[3]; F.conv_w = args.in[4]; F.wgf = args.in[5]; F.bgf = args.in[6];
    F.wgb = args.in[7]; F.bgb = args.in[8]; F.gn = args.in[9]; F.w_oc = args.in[10]; F.w_og = args.in[11]; F.w_mo = args.in[12]; F.g_post = args.in[13];
    F.out = args.out; F.ws = args.ws;
    const int lo = args.ph_lo, hi = args.ph_hi;
#define IN(k) (lo <= (k) && (k) < hi)
    cg::grid_group grid = cg::this_grid();
    if (F.tid < 16) ((volatile LAS unsigned*)(F.lds + MISC_OFF))[F.tid] = 0u;
    __syncthreads();
    const XcdBarrier xbar = xcd_barrier_post((unsigned*)(args.ws + WS_CTL), (volatile LAS unsigned*)(F.lds + MISC_OFF));
#define SEAM(k) do { if (IN(k) && IN((k) + 1)) { if ((k) == 0) grid.sync(); else xcd_barrier(xbar); } } while (0)
    unsigned char* ws = args.ws; unsigned char* dob = (unsigned char*)args.out;
    if (IN(0)) { p0_prologue(F); }
    SEAM(0);
    if (IN(1)) {
        if (blockIdx.x < META_JOBS) meta_reduce(F, (int)blockIdx.x);
        pg8::Gemm g{(const bf16_t*)(ws + WS_U), (const bf16_t*)(ws + WS_WIN), M, NSLOT, D}; pg8::StaticOrder S; S.init(M, NSLOT, F.G, (int)blockIdx.x);
        for (int i = F.tid; i < NWAVES * CONV_STG_WAVE / 4; i += NWAVES * 64) ((LAS unsigned*)(F.lds + CONV_STG))[i] = 0u;
        __syncthreads();
        pg8::EpiProj E{(bf16_t*)(ws + WS_SIDEP), (bf16_t*)(ws + WS_SIDEG), (bf16_t*)(ws + WS_A2), (bf16_t*)(dob + DO_Q), (bf16_t*)(dob + DO_K), (bf16_t*)(ws + WS_V), (bf16_t*)(ws + WS_SA), (bf16_t*)(ws + WS_SB), (float*)(ws + WS_LR),
                       F.conv_w, F.lds + CONV_STG + F.wave * CONV_STG_WAVE};
        pg8::gemm_phase<pg8::EpiProj, pg8::StaticOrder>(F.lds, g, S, E);
    }
    SEAM(1);
    if (IN(2)) {
        conv_fixup(F);
        gla::Tensors X{(const bf16_t*)(dob + DO_Q), (const bf16_t*)(dob + DO_K), (const bf16_t*)(ws + WS_V), (const float*)(ws + WS_LR),
                       (const bf16_t*)(ws + WS_META + META_K), (const bf16_t*)(ws + WS_META + META_V), (const float*)(ws + WS_META + META_LR),
                       F.wgf, F.bgf, F.wgb, F.bgb, (bf16_t*)(dob + DO_OF), (bf16_t*)(ws + WS_OB), (bf16_t*)(ws + WS_A2), F.gn};
        { const int u = (int)blockIdx.x; gla::unit(F.lds, X, u >> 3, (u >> 1) & 3, u & 1, xbar); }
    }
    SEAM(2);
    if (IN(4)) {
        pg8::Gemm g{(const bf16_t*)(ws + WS_A2), (const bf16_t*)(ws + WS_WMG), M, D, 2 * D}; pg8::StaticOrder S; S.init(M, D, F.G, (int)blockIdx.x);
        pg8::EpiMerge E{(const bf16_t*)(ws + WS_SA), (const bf16_t*)(ws + WS_SB), (bf16_t*)(ws + WS_MERGED)};
        pg8::gemm_phase<pg8::EpiMerge, pg8::StaticOrder>(F.lds, g, S, E);
    }
    SEAM(4);
    if (IN(5)) {
        pg8::Gemm g{(const bf16_t*)(ws + WS_MERGED), (const bf16_t*)(ws + WS_WOUT), M, D, D}; pg8::StaticOrder S; S.init(M, D, F.G, (int)blockIdx.x);
        pg8::EpiOut E{(bf16_t*)(ws + WS_RAW), (float*)(ws + WS_STATS)};
        pg8::gemm_phase<pg8::EpiOut, pg8::StaticOrder>(F.lds, g, S, E);
    }
    SEAM(5);
    if (IN(6)) { p6_final(F); }
#undef IN
#undef SEAM
}

extern "C" void kernel_launch(void* const* d_in, const int* in_sizes, int n_in, void* d_out, int out_size, void* d_ws, size_t ws_size, hipStream_t stream) {
    static int grid = 0;
    if (grid == 0) {
        if (n_in != 14 || in_sizes[0] != M * D || out_size != M * D || ws_size < WS_END) {
            fprintf(stderr, "kernel_launch: unexpected shapes (n_in %d, in0 %d, out %d, ws %zu; need ws >= %zu); nothing launched\n", n_in, n_in > 0 ? in_sizes[0] : -1, out_size, ws_size, (size_t)WS_END); grid = -1; return; }
        int dev = 0, cus = 0, per_cu = 0;
        if (hipGetDevice(&dev) != hipSuccess || hipDeviceGetAttribute(&cus, hipDeviceAttributeMultiprocessorCount, dev) != hipSuccess) { grid = -1; return; }
        if (hipFuncSetAttribute((const void*)fwd_kernel, hipFuncAttributeMaxDynamicSharedMemorySize, LDS_BYTES) != hipSuccess) { fprintf(stderr, "kernel_launch: hipFuncSetAttribute failed\n"); grid = -1; return; }
        if (hipOccupancyMaxActiveBlocksPerMultiprocessor(&per_cu, (const void*)fwd_kernel, NWAVES * 64, LDS_BYTES) != hipSuccess || per_cu < 1) { fprintf(stderr, "kernel_launch: occupancy query says %d blocks per CU\n", per_cu); per_cu = 1; }
        (void)hipGetLastError();
        grid = cus;
        if (grid != NB * NH * 2) { fprintf(stderr, "kernel_launch: this kernel needs exactly %d workgroups (one GLA unit each); the device has %d CUs; nothing launched\n", NB * NH * 2, cus); grid = -1; return; }
    }
    if (grid < 0) return;
    Args a{};
    for (int i = 0; i < 14; ++i) a.in[i] = (const float*)d_in[i];
    a.out = (float*)d_out; a.ws = (unsigned char*)d_ws;
    if (hipMemsetAsync((char*)d_ws + WS_CTL, 0, CTL_BYTES, stream) != hipSuccess) { fprintf(stderr, "kernel_launch: memset of the barrier words failed\n"); return; }
    a.ph_lo = 0; a.ph_hi = 7;
    void* params[] = {&a};
    hipError_t e = hipLaunchCooperativeKernel((const void*)fwd_kernel, dim3(grid), dim3(NWAVES * 64), params, LDS_BYTES, stream);
    if (e != hipSuccess) fprintf(stderr, "kernel_launch: cooperative launch failed: %s (grid %d)\n", hipGetErrorString(e), grid);
}
```

```cpp
#include <hip/hip_runtime.h>
#include <hip/hip_cooperative_groups.h>
#include <cstdio>
#include <cstdint>
namespace cg = cooperative_groups;

#define LAS __attribute__((address_space(3)))
typedef unsigned short bf16_t;
typedef short bf16x8 __attribute__((ext_vector_type(8)));
typedef short s16x4 __attribute__((ext_vector_type(4)));
typedef float f32x4 __attribute__((ext_vector_type(4)));
typedef float f32x2 __attribute__((ext_vector_type(2)));
typedef float f32x16 __attribute__((ext_vector_type(16)));
typedef unsigned u32x4 __attribute__((ext_vector_type(4)));
typedef unsigned u32x2 __attribute__((ext_vector_type(2)));
typedef __bf16 bf2_t __attribute__((ext_vector_type(2)));

__device__ __forceinline__ unsigned pk2(float lo, float hi) { f32x2 v = {lo, hi}; bf2_t b = __builtin_convertvector(v, bf2_t); return __builtin_bit_cast(unsigned, b); }
__device__ __forceinline__ float bflo(unsigned w) { return __builtin_bit_cast(float, w << 16); }
__device__ __forceinline__ float bfhi(unsigned w) { return __builtin_bit_cast(float, w & 0xffff0000u); }
__device__ __forceinline__ float sigm(float x) { return __builtin_amdgcn_rcpf(1.f + __expf(-x)); }
#define LDS_WAIT() asm volatile("s_waitcnt lgkmcnt(0)" ::: "memory")
#define LBAR() do { asm volatile("s_waitcnt lgkmcnt(0)" ::: "memory"); __builtin_amdgcn_s_barrier(); asm volatile("" ::: "memory"); } while (0)

typedef __amdgpu_buffer_rsrc_t rsrc_t;
typedef unsigned v4u_t __attribute__((__vector_size__(16)));
__device__ __forceinline__ rsrc_t mk_rsrc(const void* p, unsigned bytes) { return __builtin_amdgcn_make_buffer_rsrc((void*)p, (short)0, (int)bytes, 0x00020000); }
__device__ __forceinline__ u32x4 bld128(rsrc_t r, unsigned voff, unsigned soff) { return __builtin_bit_cast(u32x4, __builtin_amdgcn_raw_buffer_load_b128(r, (int)voff, (int)soff, 0)); }
__device__ __forceinline__ void bst128(u32x4 v, rsrc_t r, unsigned voff, unsigned soff) { __builtin_amdgcn_raw_buffer_store_b128(__builtin_bit_cast(v4u_t, v), r, (int)voff, (int)soff, 0); }

constexpr int NB = 32, T = 2048, D = 1024, M = NB * T;
constexpr int NIN = 9248, NSLOT = 9472;
constexpr int NH = 4, DK = 128, DV = 256, CH = 64;
constexpr float EPS = 1e-6f;
constexpr int O_CB = 0, O_CC = 1024, O_CX = 2048, O_CZ = 3072, O_Q = 4096, O_K = 4608, O_V = 5120, O_R = 6144, O_LRF = 7168, O_LRB = 7184, O_MA = 7200, O_MB = 8224;

constexpr size_t MiB = 1u << 20;
constexpr size_t WS_WIN = 1 * MiB, WS_WMG = 20 * MiB, WS_WOUT = 24 * MiB, WS_META = 26 * MiB, WS_LR = 27 * MiB, WS_STATS = 35 * MiB;
constexpr size_t WS_P = 64 * MiB, WS_A2 = 192 * MiB, WS_V = 448 * MiB, WS_SA = 576 * MiB, WS_SB = 704 * MiB, WS_OB = 832 * MiB, WS_END = 960 * MiB;
constexpr size_t WS_SIDEP = 40 * MiB, WS_SIDEG = 44 * MiB;
constexpr size_t WS_MERGED = WS_OB;
constexpr size_t WS_U = WS_P, WS_RMS = 52 * MiB;
constexpr size_t WS_RAW = WS_V;
constexpr size_t META_K = 0, META_V = 65536, META_LR = 65536 + 131072, META_CC = META_LR + 8192, META_CX = META_CC + 4096;
constexpr size_t DO_U = 0, DO_OF = 0, DO_Q = 128 * MiB, DO_K = 192 * MiB;

namespace pg8 {
constexpr int BM = 256, BK = 64, HALF = 128, HTB = HALF * BK * 2, STAGE_BYTES = 8 * HTB, NXCD = 8, WGM = 8;
__host__ __device__ __forceinline__ int lds_byte(int r, int c) { const int st = (r >> 4) * 2 + (c >> 5), rr = r & 15, cc = c & 31, ob = rr * 64 + cc * 2; return st * 1024 + (ob ^ (((ob >> 9) & 1) << 5)); }
__host__ __device__ __forceinline__ void stage_rc(int b, int& R, int& C) { const int st = b / 1024, sb = b % 1024, swz = sb ^ (((sb >> 9) & 1) << 5); R = (st >> 1) * 16 + swz / 64; C = (st & 1) * 32 + (swz % 64) / 2; }
struct Unit { int pm, pn; };
struct Gemm { const bf16_t* A; const bf16_t* Bt; int M, N, K; };
struct StaticOrder {
    int nM, nN, nwg, G, c;
    __host__ __device__ void init(int M_, int N_, int G_, int c_) { nM = M_ / BM; nN = N_ / BM; nwg = nM * nN; G = G_; c = c_; }
    __host__ __device__ bool next(int i, Unit& u) const {
        const long L = (long)i * G + c; if (L >= nwg) return false;
        int wgid = (int)L; { const int q = nwg / NXCD, r = nwg % NXCD, xcd = wgid % NXCD, off = wgid / NXCD; wgid = (xcd < r ? xcd * (q + 1) : r * (q + 1) + (xcd - r) * q) + off; }
        const int nig = WGM * nN, gid = wgid / nig, fm = gid * WGM, gsz = (nM - fm) < WGM ? (nM - fm) : WGM;
        u.pm = fm + ((wgid % nig) % gsz); u.pn = (wgid % nig) / gsz; return true;
    }
};

__device__ __forceinline__ float sig_fast(float x) { return __builtin_amdgcn_rcpf(1.f + __builtin_amdgcn_exp2f(-1.4426950408889634f * x)); }
struct EpiProj {
    static constexpr bool AFTER_DRAIN = false, MID = false;
    bf16_t *SIDEP, *SIDEG, *A2, *Q, *K, *V, *RA, *SB; float* LR; const float* convw; LAS unsigned char* stage;
    __device__ __forceinline__ void mid(f32x4 (&)[2][2][4][2], const Unit&, int, int, int, int) const {}
    __device__ __forceinline__ void plain(const f32x4 (&acc)[2][2][4][2], bf16_t* base, int ld, int row0, int col0, float scale) const {
#pragma unroll
        for (int ai = 0; ai < 2; ++ai)
#pragma unroll
            for (int m = 0; m < 4; ++m) {
                bf16_t* rowp = base + (size_t)(row0 + ai * HALF + m * 16) * ld + col0;
#pragma unroll
                for (int bj = 0; bj < 2; ++bj) {
                    const f32x4 v0 = acc[ai][bj][m][0] * scale, v1 = acc[ai][bj][m][1] * scale;
                    *(u32x4*)(rowp + bj * HALF) = (u32x4){pk2(v0[0], v0[1]), pk2(v0[2], v0[3]), pk2(v1[0], v1[1]), pk2(v1[2], v1[3])};
                }
            }
    }
    __device__ __forceinline__ void operator()(const f32x4 (&acc)[2][2][4][2], const Unit& u, int wr, int wc, int fr, int fq) const {
        const int row0 = u.pm * BM + wr * 64 + fr; const int pn = u.pn;
        if (pn < 16) {
            const int ch0 = pn * 64 + wc * 16 + fq * 4;
            const f32x4 w0 = *(const f32x4*)(convw + ch0), w1 = *(const f32x4*)(convw + D + ch0), w2 = *(const f32x4*)(convw + 2 * D + ch0);
            LAS unsigned char* stg = stage + (fr + 1) * 32 + fq * 8;
#pragma unroll
            for (int ai = 0; ai < 2; ++ai) {
                f32x4 p[4], g[4];
#pragma unroll
                for (int m = 0; m < 4; ++m) {
                    const f32x4 cb = acc[ai][0][m][0], cc = acc[ai][0][m][1], cx = acc[ai][1][m][0], cz = acc[ai][1][m][1];
                    p[m] = cc * cx; g[m] = cb * cz;
#pragma unroll
                    for (int e = 0; e < 4; ++e) g[m][e] *= sig_fast(cz[e]);
                    *(LAS u32x2*)(stg + m * 512) = (u32x2){pk2(p[m][0], p[m][1]), pk2(p[m][2], p[m][3])};
                }
                asm volatile("s_waitcnt lgkmcnt(0)" ::: "memory");
                const int run = u.pm * 4 + ai * 2 + wr;
#pragma unroll
                for (int m = 0; m < 4; ++m) {
                    const size_t row = (size_t)(row0 + ai * HALF + m * 16);
                    const u32x2 a = *(const LAS u32x2*)(stg + m * 512 - 32), b = *(const LAS u32x2*)(stg + m * 512 + 32);
                    const f32x4 pm = {bflo(a.x), bfhi(a.x), bflo(a.y), bfhi(a.y)}, pp = {bflo(b.x), bfhi(b.x), bflo(b.y), bfhi(b.y)};
                    const f32x4 y = g[m] * (w0 * pm + w1 * p[m] + w2 * pp);
                    *(u32x2*)(A2 + row * (2 * D) + ch0) = (u32x2){pk2(y[0], y[1]), pk2(y[2], y[3])};
                    if ((m == 0 && fr == 0) || (m == 3 && fr == 15)) {
                        const size_t so = ((size_t)run * 2 + (m == 3 ? 1 : 0)) * D + ch0;
                        *(u32x2*)(SIDEP + so) = (u32x2){pk2(p[m][0], p[m][1]), pk2(p[m][2], p[m][3])};
                        *(u32x2*)(SIDEG + so) = (u32x2){pk2(g[m][0], g[m][1]), pk2(g[m][2], g[m][3])};
                    }
                }
                asm volatile("" ::: "memory");
            }
        } else if (pn < 24) {
            const int col0 = wc * 32 + fq * 8;
            if (pn < 18)      plain(acc, Q, 512, row0, (pn - 16) * 256 + col0, 0.08838834764831845f);
            else if (pn < 20) plain(acc, K, 512, row0, (pn - 18) * 256 + col0, 1.f);
            else              plain(acc, V, D, row0, (pn - 20) * 256 + col0, 1.f);
        } else if (pn < 28) {
            plain(acc, A2, 2 * D, row0, D + (pn - 24) * 256 + wc * 32 + fq * 8, 1.f);
        } else if (pn < 36) {
            const int col0 = (pn - 28) * 128 + wc * 32 + fq * 8;
#pragma unroll
            for (int ai = 0; ai < 2; ++ai)
#pragma unroll
                for (int m = 0; m < 4; ++m) {
                    const size_t off = (size_t)(row0 + ai * HALF + m * 16) * D + col0;
                    float ra[8], sb[8];
#pragma unroll
                    for (int n = 0; n < 2; ++n)
#pragma unroll
                        for (int e = 0; e < 4; ++e) {
                            const float ea = 1.f + __builtin_amdgcn_exp2f(-1.4426950408889634f * acc[ai][0][m][n][e]), eb = 1.f + __builtin_amdgcn_exp2f(-1.4426950408889634f * acc[ai][1][m][n][e]);
                            ra[4 * n + e] = eb * __builtin_amdgcn_rcpf(ea); sb[4 * n + e] = __builtin_amdgcn_rcpf(eb);
                        }
                    *(u32x4*)(RA + off) = (u32x4){pk2(ra[0], ra[1]), pk2(ra[2], ra[3]), pk2(ra[4], ra[5]), pk2(ra[6], ra[7])};
                    *(u32x4*)(SB + off) = (u32x4){pk2(sb[0], sb[1]), pk2(sb[2], sb[3]), pk2(sb[4], sb[5]), pk2(sb[6], sb[7])};
                }
        } else {
            if (wc == 0) {
#pragma unroll
                for (int ai = 0; ai < 2; ++ai)
#pragma unroll
                    for (int m = 0; m < 4; ++m) {
                        float* rowp = LR + (size_t)(row0 + ai * HALF + m * 16) * 32 + 4 * fq;
                        *(f32x4*)(rowp) = acc[ai][0][m][0]; *(f32x4*)(rowp + 16) = acc[ai][0][m][1];
                    }
            }
        }
    }
};
struct EpiMerge {
    static constexpr bool AFTER_DRAIN = false, MID = true;
    const bf16_t *SA, *SB; bf16_t* O;
    __device__ __forceinline__ void mid(f32x4 (&acc)[2][2][4][2], const Unit& u, int wr, int wc, int fr, int fq) const {
        const rsrc_t ra = mk_rsrc(SA, (unsigned)((size_t)M * D * 2));
        const unsigned voff = (unsigned)((wr * 64 + fr) * D + wc * 32 + fq * 8) * 2u;
        const unsigned uoff = (unsigned)(u.pm * BM * D + u.pn * BM) * 2u;
#pragma unroll
        for (int ai = 0; ai < 2; ++ai)
#pragma unroll
            for (int m = 0; m < 4; ++m)
#pragma unroll
                for (int bj = 0; bj < 2; ++bj) {
                    const unsigned so = uoff + (unsigned)((ai * HALF + m * 16) * D + bj * HALF) * 2u;
                    const u32x4 a = bld128(ra, voff, so);
                    acc[ai][bj][m][0] *= (f32x4){bflo(a.x), bfhi(a.x), bflo(a.y), bfhi(a.y)}; acc[ai][bj][m][1] *= (f32x4){bflo(a.z), bfhi(a.z), bflo(a.w), bfhi(a.w)};
                }
    }
    __device__ __forceinline__ void operator()(const f32x4 (&acc)[2][2][4][2], const Unit& u, int wr, int wc, int fr, int fq) const {
        const rsrc_t rb = mk_rsrc(SB, (unsigned)((size_t)M * D * 2)), ro = mk_rsrc(O, (unsigned)((size_t)M * D * 2));
        const unsigned voff = (unsigned)((wr * 64 + fr) * D + wc * 32 + fq * 8) * 2u;
        const unsigned uoff = (unsigned)(u.pm * BM * D + u.pn * BM) * 2u;
#pragma unroll
        for (int ai = 0; ai < 2; ++ai)
#pragma unroll
            for (int m = 0; m < 4; ++m)
#pragma unroll
                for (int bj = 0; bj < 2; ++bj) {
                    const unsigned so = uoff + (unsigned)((ai * HALF + m * 16) * D + bj * HALF) * 2u;
                    const u32x4 b = bld128(rb, voff, so);
                    const f32x4 v0 = acc[ai][bj][m][0], v1 = acc[ai][bj][m][1];
                    u32x4 w;
                    w.x = pk2(v0[0] * bflo(b.x), v0[1] * bfhi(b.x)); w.y = pk2(v0[2] * bflo(b.y), v0[3] * bfhi(b.y));
                    w.z = pk2(v1[0] * bflo(b.z), v1[1] * bfhi(b.z)); w.w = pk2(v1[2] * bflo(b.w), v1[3] * bfhi(b.w));
                    bst128(w, ro, voff, so);
                }
    }
};
struct EpiOut {
    static constexpr bool AFTER_DRAIN = false, MID = false;
    bf16_t* C; float* stats;
    __device__ __forceinline__ void mid(f32x4 (&)[2][2][4][2], const Unit&, int, int, int, int) const {}
    __device__ __forceinline__ void operator()(const f32x4 (&acc)[2][2][4][2], const Unit& u, int wr, int wc, int fr, int fq) const {
        const int row0 = u.pm * BM + wr * 64 + fr, col0 = u.pn * BM + wc * 32 + 8 * fq;
#pragma unroll
        for (int ai = 0; ai < 2; ++ai)
#pragma unroll
            for (int m = 0; m < 4; ++m) {
                const size_t row = (size_t)(row0 + ai * HALF + m * 16);
                bf16_t* rowp = C + row * D + col0; float s = 0.f;
#pragma unroll
                for (int bj = 0; bj < 2; ++bj) {
                    const f32x4 v0 = acc[ai][bj][m][0], v1 = acc[ai][bj][m][1];
                    s += ((v0[0] * v0[0] + v0[1] * v0[1]) + (v0[2] * v0[2] + v0[3] * v0[3])) + ((v1[0] * v1[0] + v1[1] * v1[1]) + (v1[2] * v1[2] + v1[3] * v1[3]));
                    *(u32x4*)(rowp + bj * HALF) = (u32x4){pk2(v0[0], v0[1]), pk2(v0[2], v0[3]), pk2(v1[0], v1[1]), pk2(v1[2], v1[3])};
                }
                s += __shfl_xor(s, 16); s += __shfl_xor(s, 32);
                if (fq == 0) stats[row * 16 + u.pn * 4 + wc] = s;
            }
    }
};

template <class Epi, class Sched>
__device__ __forceinline__ void gemm_phase(LAS unsigned char* lds, const Gemm g, const Sched& S, const Epi& E) {
    const int tid = threadIdx.x, wid = __builtin_amdgcn_readfirstlane(tid >> 6), lane = tid & 63, wr = wid >> 2, wc = wid & 3, fr = lane & 15, fq = lane >> 4;
    const int K = g.K, nt = K / BK;
    unsigned voffA[2];
#pragma unroll
    for (int i = 0; i < 2; ++i) { int R, C; stage_rc(tid * 16 + i * 8192, R, C); voffA[i] = (unsigned)(R * K + C) * 2u; }
    const size_t kstep = (size_t)(BK * 2);
    const size_t hstep = (size_t)HALF * K * 2;
    const size_t tstep = 2 * hstep;
    const unsigned ldsw = (unsigned)wid * 1024u;
    const int aoff = lds_byte(wr * 64 + fr, fq * 8), boff = lds_byte(wc * 32 + fr, fq * 8);
#define PG8_SA(b, h) (((b) * 2 + (h)) * HTB)
#define PG8_SB(b, h) ((4 + (b) * 2 + (h)) * HTB)
#define PG8_STAGE(bufoff, gbase) do { _Pragma("unroll") for (int _i = 0; _i < 2; ++_i) \
        __builtin_amdgcn_global_load_lds((const unsigned*)((const char*)(gbase) + voffA[_i]), (LAS unsigned*)(lds + (bufoff) + ldsw + _i * 8192), 16, 0, 0); } while (0)
#define PG8_LDA(dst, b, h) do { _Pragma("unroll") for (int m = 0; m < 4; ++m) _Pragma("unroll") for (int k = 0; k < 2; ++k) dst[m][k] = *(const LAS bf16x8*)(lds + PG8_SA(b, h) + aoff + m * 2048 + k * 1024); } while (0)
#define PG8_LDB(dst, b, h) do { _Pragma("unroll") for (int n = 0; n < 2; ++n) _Pragma("unroll") for (int k = 0; k < 2; ++k) dst[n][k] = *(const LAS bf16x8*)(lds + PG8_SB(b, h) + boff + n * 2048 + k * 1024); } while (0)
#define PG8_MMA(ai, bj, At, Bt) do { __builtin_amdgcn_s_setprio(1); _Pragma("unroll") for (int m = 0; m < 4; ++m) _Pragma("unroll") for (int n = 0; n < 2; ++n) _Pragma("unroll") for (int k = 0; k < 2; ++k) \
        acc[ai][bj][m][n] = __builtin_amdgcn_mfma_f32_16x16x32_bf16(Bt[n][k], At[m][k], acc[ai][bj][m][n], 0, 0, 0); __builtin_amdgcn_s_setprio(0); } while (0)
#define PG8_WAIT_V(n) asm volatile("s_waitcnt vmcnt(" #n ")" ::: "memory")
#define PG8_WAIT_L(n) asm volatile("s_waitcnt lgkmcnt(" #n ")" ::: "memory")
#define PG8_BAR __builtin_amdgcn_s_barrier()
#define PG8_SCHED __builtin_amdgcn_sched_barrier(0)
    Unit cur, nxt; int ui = 0;
    if (!S.next(0, cur)) return;
    f32x4 acc[2][2][4][2];
#pragma unroll
    for (int a = 0; a < 2; ++a)
#pragma unroll
        for (int b = 0; b < 2; ++b)
#pragma unroll
            for (int m = 0; m < 4; ++m)
#pragma unroll
                for (int n = 0; n < 2; ++n) acc[a][b][m][n] = (f32x4){0.f, 0.f, 0.f, 0.f};
    bf16x8 At[4][2], B0[2][2], B1[2][2];
    const char* cA = (const char*)g.A + (size_t)cur.pm * tstep; const char* cB = (const char*)g.Bt + (size_t)cur.pn * tstep;
    PG8_STAGE(PG8_SB(0, 0), cB); PG8_STAGE(PG8_SB(0, 1), cB + hstep); PG8_STAGE(PG8_SA(0, 0), cA); PG8_STAGE(PG8_SA(0, 1), cA + hstep);
    if (wr == 1) PG8_BAR;
    PG8_WAIT_V(2); PG8_BAR;
    PG8_STAGE(PG8_SB(1, 0), cB + kstep); PG8_STAGE(PG8_SA(1, 0), cA + kstep); PG8_STAGE(PG8_SB(1, 1), cB + hstep + kstep);
    PG8_WAIT_V(6); PG8_BAR;
    for (;;) {
        const bool has_next = S.next(ui + 1, nxt);
        const char* nA = has_next ? (const char*)g.A + (size_t)nxt.pm * tstep : cA; const char* nB = has_next ? (const char*)g.Bt + (size_t)nxt.pn * tstep : cB;
        for (int part = 0; part < (Epi::MID ? 2 : 1); ++part) {
        const int t_lo = part ? (nt >> 1) : 0, t_hi = (Epi::MID && part == 0) ? (nt >> 1) : nt;
        if constexpr (Epi::MID) { if (part == 1) E.mid(acc, cur, wr, wc, fr, fq); }
        for (int t = t_lo; t < t_hi; t += 2) {
            const bool last = (t == nt - 2);
            const char* a1 = cA + (size_t)(t + 1) * kstep;
            const char* a2 = last ? nA : cA + (size_t)(t + 2) * kstep; const char* b2 = last ? nB : cB + (size_t)(t + 2) * kstep;
            const char* a3 = a2 + kstep; const char* b3 = b2 + kstep;
            PG8_LDB(B0, 0, 0); PG8_LDB(B1, 0, 1); PG8_SCHED; PG8_LDA(At, 0, 0); PG8_STAGE(PG8_SA(1, 1), a1 + hstep);
            PG8_WAIT_V(8); PG8_WAIT_L(0); PG8_BAR; PG8_MMA(0, 0, At, B0); PG8_MMA(0, 1, At, B1); PG8_BAR; PG8_SCHED;
            PG8_LDA(At, 0, 1); PG8_STAGE(PG8_SB(0, 0), b2); PG8_STAGE(PG8_SB(0, 1), b2 + hstep); PG8_STAGE(PG8_SA(0, 0), a2);
            PG8_WAIT_V(8); PG8_WAIT_L(0); PG8_BAR; PG8_MMA(1, 0, At, B0); PG8_MMA(1, 1, At, B1); PG8_BAR; PG8_SCHED;
            PG8_LDB(B0, 1, 0); PG8_LDB(B1, 1, 1); PG8_SCHED; PG8_LDA(At, 1, 0); PG8_STAGE(PG8_SA(0, 1), a2 + hstep);
            PG8_WAIT_V(8); PG8_WAIT_L(0); PG8_BAR; PG8_MMA(0, 0, At, B0); PG8_MMA(0, 1, At, B1); PG8_BAR; PG8_SCHED;
            PG8_LDA(At, 1, 1); PG8_STAGE(PG8_SB(1, 0), b3); PG8_STAGE(PG8_SB(1, 1), b3 + hstep); PG8_STAGE(PG8_SA(1, 0), a3);
            PG8_WAIT_V(8); PG8_WAIT_L(0); PG8_BAR; PG8_MMA(1, 0, At, B0); PG8_MMA(1, 1, At, B1); PG8_BAR; PG8_SCHED;
        }
        }
        if (wr == 0) PG8_BAR;
        E(acc, cur, wr, wc, fr, fq);
        if (!has_next) break;
#pragma unroll
        for (int a = 0; a < 2; ++a)
#pragma unroll
            for (int b = 0; b < 2; ++b)
#pragma unroll
                for (int m = 0; m < 4; ++m)
#pragma unroll
                    for (int n = 0; n < 2; ++n) acc[a][b][m][n] = (f32x4){0.f, 0.f, 0.f, 0.f};
        cur = nxt; cA = nA; cB = nB; ++ui;
        if (wr == 1) PG8_BAR;
    }
    PG8_WAIT_V(0);
    PG8_BAR;
#undef PG8_SA
#undef PG8_SB
#undef PG8_STAGE
#undef PG8_LDA
#undef PG8_LDB
#undef PG8_MMA
#undef PG8_WAIT_V
#undef PG8_WAIT_L
#undef PG8_BAR
#undef PG8_SCHED
}
}

#define XB_TMO      128
#define XB_XCNT(j)  (256  + 64 * (j))
#define XB_XSUB(j)  (1280 + 64 * (j))
#define XB_XGEN(j)  (2304 + 64 * (j))
#define XB_TOP      3328
#define XB_TOPGEN   3392
#define XCD_BAR_WORDS 3456
#define XB_SPIN_CAP (1u << 18)
__device__ __forceinline__ unsigned xb_ld(unsigned* p)              { return __hip_atomic_load(p, __ATOMIC_RELAXED, __HIP_MEMORY_SCOPE_AGENT); }
__device__ __forceinline__ unsigned xb_add(unsigned* p, unsigned v) { return __hip_atomic_fetch_add(p, v, __ATOMIC_RELAXED, __HIP_MEMORY_SCOPE_AGENT); }
__device__ __forceinline__ unsigned xb_xcc_id() { return (unsigned)__builtin_amdgcn_s_getreg((3 << 11) | 20) & 0xFu; }
#define XB_SPIN(cond, bar) do { unsigned _sp = 0; while (cond) { __builtin_amdgcn_s_sleep(1); \
    if ((++_sp & 255u) == 0u) { if (xb_ld(&(bar)[XB_TMO])) break; if (_sp > XB_SPIN_CAP) { atomicAdd(&(bar)[XB_TMO], 1u); break; } } } } while (0)
struct XcdBarrier { unsigned* bar; unsigned x; volatile LAS unsigned* st; };
__device__ __forceinline__ XcdBarrier xcd_barrier_post(unsigned* bar, volatile LAS unsigned* st) {
    XcdBarrier b; b.bar = bar; b.x = xb_xcc_id(); b.st = st;
    if (threadIdx.x == 0) (void)xb_add(&bar[XB_XCNT(b.x)], 1u);
    return b;
}
__device__ __forceinline__ void xcd_barrier_complete(unsigned* bar, unsigned x, unsigned& nloc, unsigned& nx) {
    const unsigned G = gridDim.x * gridDim.y * gridDim.z;
    unsigned sum, cnt, mine, sp = 0u;
    for (;;) {
        sum = 0u; cnt = 0u; mine = 0u;
#pragma unroll
        for (unsigned j = 0; j < 16; ++j) { const unsigned c = xb_ld(&bar[XB_XCNT(j)]); sum += c; cnt += (c > 0u) ? 1u : 0u; mine = (j == x) ? c : mine; }
        if (sum == G) break;
        __builtin_amdgcn_s_sleep(1);
        if ((++sp & 255u) == 0u) { if (xb_ld(&bar[XB_TMO])) break; if (sp > XB_SPIN_CAP) { atomicAdd(&bar[XB_TMO], 1u); break; } }
    }
    nloc = mine > 0u ? mine : 1u; nx = cnt > 0u ? cnt : 1u;
}
__device__ __forceinline__ void xcd_barrier(const XcdBarrier& b) {
    asm volatile("s_waitcnt vmcnt(0)" ::: "memory");
    __syncthreads();
    if (threadIdx.x == 0) {
        unsigned* bar = b.bar;
        __builtin_amdgcn_s_waitcnt(0);
        unsigned nloc = b.st[0], nx = b.st[1];
        if (nloc == 0u) { xcd_barrier_complete(bar, b.x, nloc, nx); b.st[0] = nloc; b.st[1] = nx; }
        const unsigned old = xb_add(&bar[XB_XSUB(b.x)], 1u);
        const unsigned gen = old / nloc;
        if (old + 1u == (gen + 1u) * nloc) {
            __builtin_amdgcn_fence(__ATOMIC_RELEASE, "agent");
            asm volatile("s_waitcnt vmcnt(0)" ::: "memory");
            const unsigned og = xb_add(&bar[XB_TOP], 1u);
            const unsigned tg = og / nx;
            if (og + 1u == (tg + 1u) * nx) xb_add(&bar[XB_TOPGEN], 1u);
            else XB_SPIN(xb_ld(&bar[XB_TOPGEN]) == tg, bar);
            __builtin_amdgcn_fence(__ATOMIC_ACQUIRE, "agent");
            xb_add(&bar[XB_XGEN(b.x)], 1u);
            asm volatile("s_waitcnt vmcnt(0)" ::: "memory");
        } else {
            XB_SPIN(xb_ld(&bar[XB_XGEN(b.x)]) == gen, bar);
            __builtin_amdgcn_fence(__ATOMIC_ACQUIRE, "agent");
            asm volatile("s_waitcnt vmcnt(0)" ::: "memory");
        }
    }
    __syncthreads();
}

namespace gla {
constexpr int QS = 272, SS = 144;
constexpr int L_QI = 0, L_KI = 17408, L_KD = 34816, L_V = 51200, L_ST = 83968, L_E = 93184, L_TOTP = 125952, L_DEC = 126976, L_O = 128000, L_GN = 160768, L_END = 161792;
__device__ __forceinline__ int v_st(int k, int c) { const int kk = (k & ~0xC) | ((k & 4) << 1) | ((k & 8) >> 1); return ((kk >> 3) * 4 + (c >> 5)) * 512 + ((kk & 7) * 32 + (c & 31)) * 2; }
__device__ __forceinline__ int v_rd_base(int lane) { return ((lane & 3) << 3) | (((lane >> 2) & 3) << 6) | (((lane >> 4) & 1) << 5) | (((lane >> 5) & 1) << 8); }
__host__ __device__ constexpr int v_rd_off(int d0, int ks, int half) { return d0 * 512 + ks * 4096 + half * 2048; }
__device__ __forceinline__ s16x4 tr_read(const LAS unsigned char* p) { return __builtin_bit_cast(s16x4, __builtin_amdgcn_ds_read_tr16_b64_v4i16((LAS s16x4*)p)); }
__device__ __forceinline__ bf16x8 cat8(s16x4 lo, s16x4 hi) { return __builtin_shufflevector(lo, hi, 0, 1, 2, 3, 4, 5, 6, 7); }
#define MFMA32(a, b, c) __builtin_amdgcn_mfma_f32_32x32x16_bf16((a), (b), (c), 0, 0, 0)
#define MFMA16(a, b, c) __builtin_amdgcn_mfma_f32_16x16x32_bf16((a), (b), (c), 0, 0, 0)

struct Tensors {
    const bf16_t *Q, *K, *V; const float* LR;
    const bf16_t *Kmeta, *Vmeta; const float* LRmeta;
    const float *wgf, *bgf, *wgb, *bgb;
    bf16_t *OF, *OB;
    bf16_t* A2; const float* gn;
};

__device__ __forceinline__ void unit(LAS unsigned char* lds, const Tensors& X, int b, int h, int dir, const XcdBarrier& xbar) {
    const int tid = threadIdx.x, lane = tid & 63, wid = __builtin_amdgcn_readfirstlane(tid >> 6), r32 = lane & 31, hi = lane >> 5;
    const int nsteps = dir ? 32 : 33, nmid = dir ? 16 : 17;
    if (tid < 64) *(LAS f32x4*)(lds + L_GN + tid * 16) = *(const f32x4*)(X.gn + tid * 4);
    if (wid < 4) {
        const int w = wid;
        f32x16 S[2][4];
#pragma unroll
        for (int ex = 0; ex < 2; ++ex)
#pragma unroll
            for (int i = 0; i < 4; ++i)
#pragma unroll
                for (int r = 0; r < 16; ++r) S[ex][i][r] = 0.f;
        const LAS unsigned char* const r_sc = lds + (lane & 15) * QS + (lane >> 4) * 16;
        LAS unsigned char* const w_st = lds + L_ST + (lane & 15) * SS + (lane >> 4) * 8;
        const LAS unsigned char* const r_qi = lds + L_QI + r32 * QS + hi * 8;
        const LAS unsigned char* const r_st = lds + L_ST + r32 * SS + hi * 16;
        const LAS unsigned char* const r_dec = lds + L_DEC + hi * 16;
        const LAS unsigned char* const vb0 = lds + L_V + (w >> 1) * 16384 + ((2 * w) & 3) * 512 + v_rd_base(lane);
        const LAS unsigned char* const kdbase = lds + L_KD + v_rd_base(lane);
        LAS unsigned char* const w_o = lds + L_O + (4 * hi) * 512 + (64 * w + r32) * 2;
        for (int n = -1; n < nsteps; ++n) {
            if (n == nmid) xcd_barrier(xbar);
            const bool second = n >= nmid;
            const int parM = (n & 1) * 512;
#pragma unroll
            for (int ti = 0; ti < 4; ++ti) {
                const int tj = w;
                f32x4 sc = {0.f, 0.f, 0.f, 0.f};
                if (dir == 0 ? (tj <= ti) : (tj >= ti)) {
                    const LAS unsigned char* pa = r_sc + L_KI + tj * (16 * QS); const LAS unsigned char* pb = r_sc + L_QI + ti * (16 * QS);
#pragma unroll
                    for (int ks = 0; ks < 4; ++ks) sc = MFMA16(*(const LAS bf16x8*)(pa + ks * 64), *(const LAS bf16x8*)(pb + ks * 64), sc);
                }
                const int i = 16 * ti + (lane & 15), j0 = 16 * tj + 4 * (lane >> 4);
#pragma unroll
                for (int r = 0; r < 4; ++r) { const int j = j0 + r; const bool keep = dir == 0 ? (j <= i) : (j > i); if (!keep) sc[r] = 0.f; }
                *(LAS u32x2*)(w_st + ti * (16 * SS) + tj * 32) = (u32x2){pk2(sc[0], sc[1]), pk2(sc[2], sc[3])};
            }
            f32x16 o[2][2];
#pragma unroll
            for (int ex = 0; ex < 2; ++ex)
#pragma unroll
                for (int r = 0; r < 16; ++r) { o[ex][0][r] = 0.f; o[ex][1][r] = 0.f; }
            {
                bf16x8 af[2][2];
#define GLA_LDQ(buf, step_) do { _Pragma("unroll") for (int it_ = 0; it_ < 2; ++it_) { const LAS unsigned char* p_ = r_qi + it_ * (32 * QS) + ((step_) >> 1) * 64 + ((step_) & 1) * 32; \
                    af[buf][it_] = cat8(*(const LAS s16x4*)(p_), *(const LAS s16x4*)(p_ + 16)); } } while (0)
                GLA_LDQ(0, 0);
#pragma unroll
                for (int st = 0; st < 8; ++st) {
                    const int dt = st >> 1, s = st & 1;
                    if (st < 7) GLA_LDQ((st + 1) & 1, st + 1);
#pragma unroll
                    for (int ex = 0; ex < 2; ++ex) {
                        u32x4 bw; bw.x = pk2(S[ex][dt][8 * s + 0], S[ex][dt][8 * s + 1]); bw.y = pk2(S[ex][dt][8 * s + 2], S[ex][dt][8 * s + 3]);
                        bw.z = pk2(S[ex][dt][8 * s + 4], S[ex][dt][8 * s + 5]); bw.w = pk2(S[ex][dt][8 * s + 6], S[ex][dt][8 * s + 7]);
                        const bf16x8 bfr = __builtin_bit_cast(bf16x8, bw);
#pragma unroll
                        for (int it = 0; it < 2; ++it) o[ex][it] = MFMA32(af[st & 1][it], bfr, o[ex][it]);
                    }
                }
#undef GLA_LDQ
            }
            LBAR();
#pragma unroll
            for (int ex = 0; ex < 2; ++ex) {
#pragma unroll
                for (int ks = 0; ks < 4; ++ks) {
                    const bf16x8 bv = cat8(tr_read(vb0 + ex * 512 + v_rd_off(0, ks, 0)), tr_read(vb0 + ex * 512 + v_rd_off(0, ks, 1)));
#pragma unroll
                    for (int it = 0; it < 2; ++it) o[ex][it] = MFMA32(*(const LAS bf16x8*)(r_st + it * (32 * SS) + ks * 32), bv, o[ex][it]);
                }
#pragma unroll
                for (int it = 0; it < 2; ++it)
#pragma unroll
                    for (int r = 0; r < 16; ++r) *(LAS bf16_t*)(w_o + ex * 64 + (32 * it + (r & 3) + 8 * (r >> 2)) * 512) = (bf16_t)(pk2(o[ex][it][r], 0.f) & 0xffffu);
            }
            LBAR();
            {
                bf16x8 Bv[2][4];
#pragma unroll
                for (int ex = 0; ex < 2; ++ex)
#pragma unroll
                    for (int ks = 0; ks < 4; ++ks) Bv[ex][ks] = cat8(tr_read(vb0 + ex * 512 + v_rd_off(0, ks, 0)), tr_read(vb0 + ex * 512 + v_rd_off(0, ks, 1)));
                bf16x8 kf[2][4];
#define GLA_LDK(buf, dt_) do { _Pragma("unroll") for (int ks_ = 0; ks_ < 4; ++ks_) kf[buf][ks_] = cat8(tr_read(kdbase + v_rd_off((dt_), ks_, 0)), tr_read(kdbase + v_rd_off((dt_), ks_, 1))); } while (0)
                GLA_LDK(0, 0);
#pragma unroll
                for (int dt = 0; dt < 4; ++dt) {
                    if (dt < 3) GLA_LDK((dt + 1) & 1, dt + 1);
#pragma unroll
                    for (int g4 = 0; g4 < 4; ++g4) {
                        const f32x4 dc = *(const LAS f32x4*)(r_dec + parM + dt * 128 + g4 * 32);
#pragma unroll
                        for (int x = 0; x < 4; ++x) { S[0][dt][4 * g4 + x] *= dc[x]; S[1][dt][4 * g4 + x] *= dc[x]; }
                    }
#pragma unroll
                    for (int ex = 0; ex < 2; ++ex)
#pragma unroll
                        for (int ks = 0; ks < 4; ++ks) S[ex][dt] = MFMA32(kf[dt & 1][ks], Bv[ex][ks], S[ex][dt]);
                }
#undef GLA_LDK
            }
            if (n < 0) {
#pragma unroll
                for (int ex = 0; ex < 2; ++ex)
#pragma unroll
                    for (int i = 0; i < 4; ++i)
#pragma unroll
                        for (int r = 0; r < 16; ++r) S[ex][i][r] = 0.f;
            }
            LBAR();
        }
    } else {
        const int w4 = wid - 4, ptid = tid - 256;
        const int gd = w4 * 32 + r32;
        const float* wg = dir ? X.wgb : X.wgf; const float* bg = dir ? X.bgb : X.bgf;
        bf16x8 Bhi, Blo;
        {
            float wv[8]; unsigned whi[4], wlo[4];
#pragma unroll
            for (int jj = 0; jj < 8; ++jj) wv[jj] = wg[(8 * hi + jj) * 512 + h * DK + gd];
#pragma unroll
            for (int p = 0; p < 4; ++p) { whi[p] = pk2(wv[2 * p], wv[2 * p + 1]); wlo[p] = pk2(wv[2 * p] - bflo(whi[p]), wv[2 * p + 1] - bfhi(whi[p])); }
            Bhi = __builtin_bit_cast(bf16x8, (u32x4){whi[0], whi[1], whi[2], whi[3]}); Blo = __builtin_bit_cast(bf16x8, (u32x4){wlo[0], wlo[1], wlo[2], wlo[3]});
        }
        const float bias = bg[h * DK + gd];
        u32x4 qreg[4], kreg[4], vreg[8]; f32x4 lrreg[2][2];
        const int qj0 = ptid >> 4, qo = ptid & 15;
        const int prow = ptid >> 4, pc = (ptid & 15) * 16;
        const unsigned lo_qk = (unsigned)(qj0 * 512 + qo * 8), lo_v = (unsigned)(qj0 * D + qo * 8), lo_lr = (unsigned)(r32 * 32 + 8 * hi);
#define GLA_CHUNK_PTRS(step_) const int s_ = (step_); const bf16_t *qp_, *kp_, *vp_; const float* lp_; \
        if (dir == 0 && s_ == 0) { qp_ = X.Kmeta + h * DK; kp_ = qp_; vp_ = X.Vmeta + h * DV; lp_ = X.LRmeta; } \
        else { const int c_ = dir ? (31 - s_) : (s_ - 1); const size_t rb_ = (size_t)b * T + (size_t)c_ * CH; \
               qp_ = X.Q + rb_ * 512 + h * DK; kp_ = X.K + rb_ * 512 + h * DK; vp_ = X.V + rb_ * D + h * DV; lp_ = X.LR + rb_ * 32 + dir * 16; } \
        (void)qp_; (void)kp_; (void)vp_; (void)lp_;
#define GLA_LOAD_QK(step_) do { GLA_CHUNK_PTRS(step_) _Pragma("unroll") for (int it = 0; it < 4; ++it) { qreg[it] = *(const u32x4*)((qp_ + it * 16 * 512) + lo_qk); kreg[it] = *(const u32x4*)((kp_ + it * 16 * 512) + lo_qk); } } while (0)
#define GLA_LOAD_V(step_) do { GLA_CHUNK_PTRS(step_) _Pragma("unroll") for (int itr = 0; itr < 4; ++itr) _Pragma("unroll") for (int itp = 0; itp < 2; ++itp) vreg[itr * 2 + itp] = *(const u32x4*)((vp_ + (16 * itr) * D + itp * 128) + lo_v); } while (0)
#define GLA_STORE_V() do { _Pragma("unroll") for (int itr = 0; itr < 4; ++itr) _Pragma("unroll") for (int itp = 0; itp < 2; ++itp) *(LAS u32x4*)(w_v + itr * 4096 + itp * 16384) = vreg[itr * 2 + itp]; } while (0)
#define GLA_LOAD_LR(step_) do { GLA_CHUNK_PTRS(step_) _Pragma("unroll") for (int tj = 0; tj < 2; ++tj) { lrreg[tj][0] = *(const f32x4*)((lp_ + tj * 32 * 32) + lo_lr); lrreg[tj][1] = *(const f32x4*)((lp_ + tj * 32 * 32 + 4) + lo_lr); } } while (0)
#define GLA_CLAMP(s_) ((s_) < nsteps ? (s_) : nsteps - 1)
        GLA_LOAD_LR(0);
        LAS unsigned char* const w_e = lds + L_E + ((4 * hi) * 128 + gd) * 4;
        const LAS unsigned char* const r_e = lds + L_E + (qj0 * 128 + qo * 8) * 4;
        const LAS unsigned char* const r_dc = lds + L_DEC + qo * 32;
        LAS unsigned char* const w_qi = lds + L_QI + qj0 * QS + qo * 16;
        LAS unsigned char* const w_kd = lds + L_KD + v_st(qj0, qo * 8);
        LAS unsigned char* const w_v = lds + L_V + v_st(qj0, qo * 8);
        const LAS unsigned char* const r_o = lds + L_O + prow * 512 + pc * 2;
        const LAS unsigned char* const r_gn = lds + L_GN + pc * 4;
        unsigned kd[4][4];
#pragma unroll
        for (int it = 0; it < 4; ++it)
#pragma unroll
            for (int p = 0; p < 4; ++p) kd[it][p] = 0u;
        for (int n = -1; n < nsteps; ++n) {
            if (n == nmid) xcd_barrier(xbar);
            const bool second = n >= nmid;
            const int parP = ((n + 1) & 1) * 512;
            if (n >= 0) {
#pragma unroll
                for (int it = 0; it < 4; ++it) *(LAS u32x4*)(w_kd + it * 4096) = (u32x4){kd[it][0], kd[it][1], kd[it][2], kd[it][3]};
            }
            GLA_LOAD_QK(GLA_CLAMP(n + 1));
            {
                float base = 0.f;
#define GLA_GATE_TILE(tj) do { \
                    const f32x4 l0 = lrreg[tj][0], l1 = lrreg[tj][1]; \
                    unsigned ah[4], al[4]; \
                    ah[0] = pk2(l0[0], l0[1]); ah[1] = pk2(l0[2], l0[3]); ah[2] = pk2(l1[0], l1[1]); ah[3] = pk2(l1[2], l1[3]); \
                    al[0] = pk2(l0[0] - bflo(ah[0]), l0[1] - bfhi(ah[0])); al[1] = pk2(l0[2] - bflo(ah[1]), l0[3] - bfhi(ah[1])); \
                    al[2] = pk2(l1[0] - bflo(ah[2]), l1[1] - bfhi(ah[2])); al[3] = pk2(l1[2] - bflo(ah[3]), l1[3] - bfhi(ah[3])); \
                    const bf16x8 Ahi = __builtin_bit_cast(bf16x8, (u32x4){ah[0], ah[1], ah[2], ah[3]}), Alo = __builtin_bit_cast(bf16x8, (u32x4){al[0], al[1], al[2], al[3]}); \
                    f32x16 z; \
                    _Pragma("unroll") for (int r = 0; r < 16; ++r) z[r] = 0.f; \
                    z = MFMA32(Ahi, Bhi, z); z = MFMA32(Ahi, Blo, z); z = MFMA32(Alo, Bhi, z); \
                    float e[16], G[4], PG[4]; \
                    _Pragma("unroll") for (int g4 = 0; g4 < 4; ++g4) { \
                        float gv[4]; \
                        _Pragma("unroll") for (int x = 0; x < 4; ++x) { const float zz = z[4 * g4 + x] + bias; \
                            gv[x] = (fminf(zz, 0.f) - 0.6931471805599453f * __builtin_amdgcn_logf(1.f + __builtin_amdgcn_exp2f(-1.4426950408889634f * fabsf(zz)))) * 0.0625f; } \
                        if (dir == 0) { e[4 * g4] = gv[0]; e[4 * g4 + 1] = gv[0] + gv[1]; e[4 * g4 + 2] = e[4 * g4 + 1] + gv[2]; e[4 * g4 + 3] = e[4 * g4 + 2] + gv[3]; G[g4] = e[4 * g4 + 3]; } \
                        else          { e[4 * g4 + 3] = gv[3]; e[4 * g4 + 2] = gv[3] + gv[2]; e[4 * g4 + 1] = e[4 * g4 + 2] + gv[1]; e[4 * g4] = e[4 * g4 + 1] + gv[0]; G[g4] = e[4 * g4]; } \
                        PG[g4] = __shfl_xor(G[g4], 32); \
                    } \
                    float pre[4], run = base; \
                    if (dir == 0) { _Pragma("unroll") for (int g4 = 0; g4 < 4; ++g4) { pre[g4] = run + (hi ? PG[g4] : 0.f); run += G[g4] + PG[g4]; } } \
                    else          { _Pragma("unroll") for (int g4 = 3; g4 >= 0; --g4) { pre[g4] = run + (hi ? 0.f : PG[g4]); run += G[g4] + PG[g4]; } } \
                    base = run; \
                    _Pragma("unroll") for (int r = 0; r < 16; ++r) *(LAS float*)(w_e + (32 * (tj) + 8 * (r >> 2) + (r & 3)) * 512) = (e[r] + pre[r >> 2]) * 1.4426950408889634f; \
                } while (0)
                if (dir == 0) { GLA_GATE_TILE(0); GLA_GATE_TILE(1); } else { GLA_GATE_TILE(1); GLA_GATE_TILE(0); }
#undef GLA_GATE_TILE
                if (hi == 0) *(LAS float*)(lds + L_DEC + parP + gd * 4) = __builtin_amdgcn_exp2f(1.4426950408889634f * base);
            }
            if (n >= 0) GLA_STORE_V();

            LBAR();
            GLA_LOAD_LR(GLA_CLAMP(n + 2));
#pragma unroll
            for (int it = 0; it < 4; ++it) {
                const f32x4 e0 = *(const LAS f32x4*)(r_e + it * 8192), e1 = *(const LAS f32x4*)(r_e + it * 8192 + 16);
                const f32x4 t0 = *(const LAS f32x4*)(r_dc + parP), t1 = *(const LAS f32x4*)(r_dc + parP + 16);
                const float ev[8] = {e0[0], e0[1], e0[2], e0[3], e1[0], e1[1], e1[2], e1[3]}, tv[8] = {t0[0], t0[1], t0[2], t0[3], t1[0], t1[1], t1[2], t1[3]};
                const unsigned qw[4] = {qreg[it].x, qreg[it].y, qreg[it].z, qreg[it].w}, kw[4] = {kreg[it].x, kreg[it].y, kreg[it].z, kreg[it].w};
                unsigned qi[4], ki[4];
#pragma unroll
                for (int p = 0; p < 4; ++p) {
                    const float q0 = bflo(qw[p]), q1 = bfhi(qw[p]);
                    const float k0 = bflo(kw[p]) * __builtin_amdgcn_exp2f(-ev[2 * p]), k1 = bfhi(kw[p]) * __builtin_amdgcn_exp2f(-ev[2 * p + 1]);
                    qi[p] = pk2(q0 * __builtin_amdgcn_exp2f(ev[2 * p]), q1 * __builtin_amdgcn_exp2f(ev[2 * p + 1]));
                    ki[p] = pk2(k0, k1);
                    kd[it][p] = pk2(k0 * tv[2 * p], k1 * tv[2 * p + 1]);
                }
                *(LAS u32x4*)(w_qi + it * 16 * QS) = (u32x4){qi[0], qi[1], qi[2], qi[3]};
                *(LAS u32x4*)(w_qi + (L_KI - L_QI) + it * 16 * QS) = (u32x4){ki[0], ki[1], ki[2], ki[3]};
                __builtin_amdgcn_sched_barrier(0);
            }
            if (!second) {
                LBAR();
                if (n >= 0 && !(dir == 0 && n == 0)) {
                    const int c = dir ? (31 - n) : (n - 1);
                    bf16_t* ob_ = (dir ? X.OB : X.OF) + ((size_t)b * T + (size_t)c * CH) * D + h * DV;
                    const unsigned lo_o = (unsigned)(prow * D + pc);
#pragma unroll
                    for (int sub = 0; sub < 4; ++sub) {
                        const u32x4 a0 = *(const LAS u32x4*)(r_o + sub * (16 * 512)), a1 = *(const LAS u32x4*)(r_o + sub * (16 * 512) + 16);
                        bf16_t* po_ = ob_ + (lo_o + (unsigned)(16 * sub * D));
                        *(u32x4*)(po_) = a0; *(u32x4*)(po_ + 8) = a1;
                    }
                }
            } else {
                u32x4 oo[2][2], rr4[2][2];
                const int c = dir ? (31 - n) : (n - 1);
                const bf16_t* ob_ = (dir ? X.OF : X.OB) + ((size_t)b * T + (size_t)c * CH) * D + h * DV;
                bf16_t* rb2_ = X.A2 + ((size_t)b * T + (size_t)c * CH) * (2 * D) + D + h * DV;
                const unsigned lo_o = (unsigned)(prow * D + pc), lo_r = (unsigned)(prow * (2 * D) + pc);
#define GLA_ROWLOAD(slot_, sub_) do { const bf16_t* po_ = ob_ + (lo_o + (unsigned)(16 * (sub_) * D)); const bf16_t* pr_ = rb2_ + (lo_r + (unsigned)(16 * (sub_) * 2 * D)); \
                    oo[slot_][0] = *(const u32x4*)(po_); oo[slot_][1] = *(const u32x4*)(po_ + 8); rr4[slot_][0] = *(const u32x4*)(pr_); rr4[slot_][1] = *(const u32x4*)(pr_ + 8); } while (0)
                GLA_ROWLOAD(0, 0); GLA_ROWLOAD(1, 1);
                LBAR();
#pragma unroll
                for (int sub = 0; sub < 4; ++sub) {
                    bf16_t* py = rb2_ + (lo_r + (unsigned)(16 * sub * 2 * D));
                    float v[16]; float ss = 0.f;
#pragma unroll
                    for (int q = 0; q < 2; ++q) {
                        const u32x4 mine = *(const LAS u32x4*)(r_o + sub * (16 * 512) + 16 * q), oth = oo[sub & 1][q];
                        v[8 * q + 0] = bflo(mine.x) + bflo(oth.x); v[8 * q + 1] = bfhi(mine.x) + bfhi(oth.x); v[8 * q + 2] = bflo(mine.y) + bflo(oth.y); v[8 * q + 3] = bfhi(mine.y) + bfhi(oth.y);
                        v[8 * q + 4] = bflo(mine.z) + bflo(oth.z); v[8 * q + 5] = bfhi(mine.z) + bfhi(oth.z); v[8 * q + 6] = bflo(mine.w) + bflo(oth.w); v[8 * q + 7] = bfhi(mine.w) + bfhi(oth.w);
                    }
                    const u32x4 rw0 = rr4[sub & 1][0], rw1 = rr4[sub & 1][1];
                    if (sub < 2) GLA_ROWLOAD(sub & 1, sub + 2);
#pragma unroll
                    for (int e2 = 0; e2 < 16; ++e2) ss += v[e2] * v[e2];
                    ss += __shfl_xor(ss, 1); ss += __shfl_xor(ss, 2); ss += __shfl_xor(ss, 4); ss += __shfl_xor(ss, 8);
                    const float rstd = 1.0f / sqrtf(ss * (1.f / DV) + EPS);
#pragma unroll
                    for (int q = 0; q < 2; ++q) {
                        const f32x4 g0 = *(const LAS f32x4*)(r_gn + 32 * q), g1 = *(const LAS f32x4*)(r_gn + 32 * q + 16);
                        const u32x4 rw = q ? rw1 : rw0;
                        const float rv[8] = {bflo(rw.x), bfhi(rw.x), bflo(rw.y), bfhi(rw.y), bflo(rw.z), bfhi(rw.z), bflo(rw.w), bfhi(rw.w)};
                        const float gg[8] = {g0[0], g0[1], g0[2], g0[3], g1[0], g1[1], g1[2], g1[3]};
                        float zz[8];
#pragma unroll
                        for (int e2 = 0; e2 < 8; ++e2) zz[e2] = v[8 * q + e2] * rstd * gg[e2] * rv[e2] * sigm(rv[e2]);
                        *(u32x4*)(py + 8 * q) = (u32x4){pk2(zz[0], zz[1]), pk2(zz[2], zz[3]), pk2(zz[4], zz[5]), pk2(zz[6], zz[7])};
                    }
                }
#undef GLA_ROWLOAD
            }
            GLA_LOAD_V(GLA_CLAMP(n + 1));
            LBAR();
        }
#undef GLA_CHUNK_PTRS
#undef GLA_LOAD_QK
#undef GLA_LOAD_V
#undef GLA_STORE_V
#undef GLA_LOAD_LR
#undef GLA_CLAMP
    }
}
}

constexpr int NWAVES = 8, LDS_BYTES = 162304, MISC_OFF = 162048, CONV_STG = 131072, CONV_STG_WAVE = 2304;
constexpr size_t WS_CTL = 0, CTL_BYTES = 16384;
struct Args { const float* in[14]; float* out; unsigned char* ws; int ph_lo, ph_hi; };
struct Frame {
    LAS unsigned char* lds; int tid, lane, wave, G, vcu;
    const float *x, *meta, *g_pre, *w_in, *conv_w, *wgf, *bgf, *wgb, *bgb, *gn, *w_oc, *w_og, *w_mo, *g_post;
    float* out; unsigned char* ws;
};
__device__ __forceinline__ int deal_row(int k, int gw, int NGW) { return k * NGW + ((gw + 488 * k) & (NGW - 1)); }
__device__ __forceinline__ float wave_sum(float v) {
#pragma unroll
    for (int o = 1; o < 64; o <<= 1) v += __shfl_xor(v, o);
    return v;
}
__device__ __forceinline__ int win_src_col(int r) {
    const int pn = r >> 8, s = r & 255, bj = s >> 7, wc = (s >> 5) & 3, n = (s >> 4) & 1, fq = (s >> 2) & 3, e = s & 3;
    if (pn < 16) return (2 * bj + n) * 1024 + pn * 64 + wc * 16 + fq * 4 + e;
    const int oc = 128 * bj + 32 * wc + 8 * fq + 4 * n + e;
    if (pn < 18) return O_Q + (pn - 16) * 256 + oc;
    if (pn < 20) return O_K + (pn - 18) * 256 + oc;
    if (pn < 24) return O_V + (pn - 20) * 256 + oc;
    if (pn < 28) return O_R + (pn - 24) * 256 + oc;
    if (pn < 36) return (bj ? O_MB : O_MA) + (pn - 28) * 128 + 32 * wc + 8 * fq + 4 * n + e;
    return s < 32 ? O_LRF + s : -1;
}
__device__ __forceinline__ int perm_col(int r) {
    const int pn = r >> 8, s = r & 255, bj = s >> 7, wc = (s >> 5) & 3, n = (s >> 4) & 1, fq = (s >> 2) & 3, e = s & 3;
    return pn * 256 + 128 * bj + 32 * wc + 8 * fq + 4 * n + e;
}
template <class SrcFn> __device__ __forceinline__ void transpose_item(SrcFn src, bf16_t* Wt, int Kd, int r0, int k0, LAS float* scr, int lane) {
    float tv[32];
#pragma unroll
    for (int i = 0; i < 32; ++i) tv[i] = src(k0 + 2 * i + (lane >> 5), r0 + (lane & 31));
#pragma unroll
    for (int i = 0; i < 32; ++i) scr[(2 * i + (lane >> 5)) * 33 + (lane & 31)] = tv[i];
    LDS_WAIT(); asm volatile("" ::: "memory");
    const int c = lane & 7;
#pragma unroll
    for (int j = 0; j < 4; ++j) { const int n = (lane >> 3) + 8 * j; const LAS float* s = scr + (8 * c) * 33 + n;
        u32x4 o; o.x = pk2(s[0 * 33], s[1 * 33]); o.y = pk2(s[2 * 33], s[3 * 33]); o.z = pk2(s[4 * 33], s[5 * 33]); o.w = pk2(s[6 * 33], s[7 * 33]);
        *(u32x4*)(Wt + (size_t)(r0 + n) * Kd + k0 + 8 * c) = o; }
    LDS_WAIT(); asm volatile("" ::: "memory");
}
constexpr int META_JOBS = 57, META_KQ = 4, META_ITEMS = META_JOBS * META_KQ, META_COLS = META_JOBS * 64;
constexpr size_t WS_MPART = 48 * MiB;
__device__ __forceinline__ void p0_meta(Frame& F, int item) {
    const int job = item >> 2, kq = item & 3;
    LAS float* umT = (LAS float*)F.lds;
    LAS float* red = (LAS float*)(F.lds + 65536);
    for (int rr = 0; rr < 2; ++rr) {
        const int j = 2 * F.wave + rr; const float* mr = F.meta + (size_t)j * D;
        f32x4 v[4]; float s = 0.f;
#pragma unroll
        for (int q = 0; q < 4; ++q) { v[q] = *(const f32x4*)(mr + 4 * F.lane + 256 * q); s += (v[q][0] * v[q][0] + v[q][1] * v[q][1]) + (v[q][2] * v[q][2] + v[q][3] * v[q][3]); }
        const float rstd = 1.0f / sqrtf(wave_sum(s) * (1.f / D) + EPS);
#pragma unroll
        for (int q = 0; q < 4; ++q)
#pragma unroll
            for (int e = 0; e < 4; ++e) { const int col = 4 * F.lane + 256 * q + e; umT[col * 16 + j] = v[q][e] * rstd * F.g_pre[col]; }
    }
    __syncthreads();
    const int ci = job * 64 + F.lane;
    const bool valid = ci < 3600;
    const int src = ci < 2048 ? (O_CC + ci) : (ci < 3584 ? (O_K + (ci - 2048)) : (valid ? O_LRF + (ci - 3584) : 0));
    float acc[16];
#pragma unroll
    for (int j = 0; j < 16; ++j) acc[j] = 0.f;
    const int kbase = kq * 256 + F.wave * 32;
    const float* wp = F.w_in + src + (size_t)kbase * NIN;
    const LAS float* up = umT + kbase * 16;
#pragma unroll 1
    for (int k0 = 0; k0 < 32; k0 += 16) {
        float w[16];
#pragma unroll
        for (int i = 0; i < 16; ++i) w[i] = wp[(size_t)(k0 + i) * NIN];
#pragma unroll
        for (int i = 0; i < 16; ++i) {
            const LAS f32x4* u4 = (const LAS f32x4*)(up + (k0 + i) * 16);
#pragma unroll
            for (int q = 0; q < 4; ++q) { const f32x4 u = u4[q]; acc[4 * q] += w[i] * u[0]; acc[4 * q + 1] += w[i] * u[1]; acc[4 * q + 2] += w[i] * u[2]; acc[4 * q + 3] += w[i] * u[3]; }
            if ((i & 1) == 1) __builtin_amdgcn_sched_barrier(0);
        }
    }
#pragma unroll
    for (int j = 0; j < 16; ++j) red[(F.wave * 16 + j) * 64 + F.lane] = acc[j];
    __syncthreads();
    float* part = (float*)(F.ws + WS_MPART) + (size_t)kq * 16 * META_COLS;
    for (int o = F.tid; o < 1024; o += NWAVES * 64) {
        const int j = o >> 6, c = o & 63;
        float s = 0.f;
#pragma unroll
        for (int w = 0; w < 8; ++w) s += red[(w * 16 + j) * 64 + c];
        part[j * META_COLS + job * 64 + c] = s;
    }
    __syncthreads();
}
__device__ __forceinline__ void meta_reduce(Frame& F, int job) {
    const float* part = (const float*)(F.ws + WS_MPART);
    unsigned char* mb = F.ws + WS_META;
    bf16_t* kmeta = (bf16_t*)(mb + META_K); bf16_t* vmeta = (bf16_t*)(mb + META_V); float* lrm = (float*)(mb + META_LR);
    for (int o = F.tid; o < 1024; o += NWAVES * 64) {
        const int j = o >> 6, c = o & 63, cj = job * 64 + c;
        float s = 0.f;
#pragma unroll
        for (int q = 0; q < META_KQ; ++q) s += part[((size_t)q * 16 + j) * META_COLS + cj];
        if (cj < 1024) { if (j == 15) ((float*)(mb + META_CC))[cj] = s; }
        else if (cj < 2048) { if (j == 15) ((float*)(mb + META_CX))[cj - 1024] = s; }
        else if (cj < 2560) kmeta[(48 + j) * 512 + (cj - 2048)] = (bf16_t)(pk2(s, 0.f) & 0xffffu);
        else if (cj < 3584) vmeta[(48 + j) * 1024 + (cj - 2560)] = (bf16_t)(pk2(s, 0.f) & 0xffffu);
        else if (cj < 3600) { lrm[(48 + j) * 32 + (cj - 3584)] = s; lrm[(48 + j) * 32 + 16 + (cj - 3584)] = 0.f; }
    }
    for (int o = F.tid; o < 48 * 64; o += NWAVES * 64) {
        const int j = o >> 6, cj = job * 64 + (o & 63);
        if (cj >= 2048 && cj < 2560) kmeta[j * 512 + (cj - 2048)] = 0;
        else if (cj >= 2560 && cj < 3584) vmeta[j * 1024 + (cj - 2560)] = 0;
        else if (cj >= 3584 && cj < 3600) { lrm[j * 32 + (cj - 3584)] = 0.f; lrm[j * 32 + 16 + (cj - 3584)] = 0.f; }
    }
}
__device__ __forceinline__ void p0_prologue(Frame& F) {
    if (blockIdx.x < META_ITEMS) p0_meta(F, (int)blockIdx.x);
    LAS float* scr = (LAS float*)(F.lds + F.wave * 16384);
    const int gw = F.vcu * NWAVES + F.wave, NGW = F.G * NWAVES;
    bf16_t* Wt_in = (bf16_t*)(F.ws + WS_WIN); bf16_t* Wt_mg = (bf16_t*)(F.ws + WS_WMG); bf16_t* Wt_out = (bf16_t*)(F.ws + WS_WOUT);
    constexpr int I_IN = (NSLOT / 32) * (D / 64), I_MG = (D / 32) * (2 * D / 64), I_OUT = (D / 32) * (D / 64);
    const float* w_in = F.w_in; const float* w_oc = F.w_oc; const float* w_og = F.w_og; const float* w_mo = F.w_mo;
    for (int it = gw; it < I_IN + I_MG + I_OUT; it += NGW) {
        int r = it;
        if (r < I_IN) { const int rb = r / (D / 64), kb = r % (D / 64);
            transpose_item([=](int k, int row) { const int c = win_src_col(row); return c < 0 ? 0.f : w_in[(size_t)k * NIN + c]; }, Wt_in, D, rb * 32, kb * 64, scr, F.lane); continue; }
        r -= I_IN;
        if (r < I_MG) { const int rb = r / (2 * D / 64), kb = r % (2 * D / 64);
            transpose_item([=](int k, int row) { const int c = perm_col(row); return k < D ? w_oc[(size_t)k * D + c] : w_og[(size_t)(k - D) * D + c]; }, Wt_mg, 2 * D, rb * 32, kb * 64, scr, F.lane); continue; }
        r -= I_MG;
        { const int rb = r / (D / 64), kb = r % (D / 64);
            transpose_item([=](int k, int row) { return w_mo[(size_t)k * D + perm_col(row)]; }, Wt_out, D, rb * 32, kb * 64, scr, F.lane); }
    }
    bf16_t* U = (bf16_t*)(F.ws + WS_U); float* rmsx = (float*)(F.ws + WS_RMS);
    f32x4 gp[4];
#pragma unroll
    for (int q = 0; q < 4; ++q) gp[q] = *(const f32x4*)(F.g_pre + 4 * F.lane + 256 * q);
    for (int k = 0; k < M / NGW; k += 2) {
        const int m = deal_row(k, gw, NGW), m2 = deal_row(k + 1, gw, NGW);
        const float* xr = F.x + (size_t)m * D + 4 * F.lane; const float* xr2 = F.x + (size_t)m2 * D + 4 * F.lane;
        f32x4 v[4], w[4]; float s = 0.f, s2 = 0.f;
#pragma unroll
        for (int q = 0; q < 4; ++q) { v[q] = __builtin_nontemporal_load((const f32x4*)(xr + 256 * q)); w[q] = __builtin_nontemporal_load((const f32x4*)(xr2 + 256 * q)); }
#pragma unroll
        for (int q = 0; q < 4; ++q) { s += (v[q][0] * v[q][0] + v[q][1] * v[q][1]) + (v[q][2] * v[q][2] + v[q][3] * v[q][3]); s2 += (w[q][0] * w[q][0] + w[q][1] * w[q][1]) + (w[q][2] * w[q][2] + w[q][3] * w[q][3]); }
        const float ms = wave_sum(s) * (1.f / D) + EPS, ms2 = wave_sum(s2) * (1.f / D) + EPS;
        const float rstd = 1.0f / sqrtf(ms), rstd2 = 1.0f / sqrtf(ms2);
        if (F.lane == 0) { rmsx[m] = sqrtf(ms); rmsx[m2] = sqrtf(ms2); }
        bf16_t* ur = U + (size_t)m * D + 4 * F.lane; bf16_t* ur2 = U + (size_t)m2 * D + 4 * F.lane;
#pragma unroll
        for (int q = 0; q < 4; ++q) { const f32x4 y = v[q] * rstd * gp[q], y2 = w[q] * rstd2 * gp[q];
            *(u32x2*)(ur + 256 * q) = (u32x2){pk2(y[0], y[1]), pk2(y[2], y[3])}; *(u32x2*)(ur2 + 256 * q) = (u32x2){pk2(y2[0], y2[1]), pk2(y2[2], y2[3])}; }
    }
}
__device__ __forceinline__ void conv_fixup(Frame& F) {
    const int gw = F.vcu * NWAVES + F.wave, NGW = F.G * NWAVES;
    const bf16_t* SP = (const bf16_t*)(F.ws + WS_SIDEP); const bf16_t* SG = (const bf16_t*)(F.ws + WS_SIDEG); bf16_t* A2 = (bf16_t*)(F.ws + WS_A2);
    const float* cc15 = (const float*)(F.ws + WS_META + META_CC); const float* cx15 = (const float*)(F.ws + WS_META + META_CX);
    for (int i = gw; i < M / 32; i += NGW) {
        const int run = i >> 1; const bool first = (i & 1) == 0;
        const int t = run * 64 + (first ? 0 : 63), tl = t & (T - 1);
#pragma unroll
        for (int half = 0; half < 2; ++half) {
            const int c0 = half * 512 + 8 * F.lane;
            const u32x4 yq = *(const u32x4*)(A2 + (size_t)t * (2 * D) + c0);
            const u32x4 gq = *(const u32x4*)(SG + ((size_t)run * 2 + (first ? 0 : 1)) * D + c0);
            float pn_[8];
            if (first ? (tl != 0) : (tl != T - 1)) {
                const u32x4 w = *(const u32x4*)(SP + ((size_t)(first ? run - 1 : run + 1) * 2 + (first ? 1 : 0)) * D + c0);
                pn_[0] = bflo(w.x); pn_[1] = bfhi(w.x); pn_[2] = bflo(w.y); pn_[3] = bfhi(w.y); pn_[4] = bflo(w.z); pn_[5] = bfhi(w.z); pn_[6] = bflo(w.w); pn_[7] = bfhi(w.w);
            } else {
#pragma unroll
                for (int e = 0; e < 8; ++e) pn_[e] = first ? cc15[c0 + e] * cx15[c0 + e] : 0.f;
            }
            const float yv[8] = {bflo(yq.x), bfhi(yq.x), bflo(yq.y), bfhi(yq.y), bflo(yq.z), bfhi(yq.z), bflo(yq.w), bfhi(yq.w)};
            const float gg[8] = {bflo(gq.x), bfhi(gq.x), bflo(gq.y), bfhi(gq.y), bflo(gq.z), bfhi(gq.z), bflo(gq.w), bfhi(gq.w)};
            float y[8];
#pragma unroll
            for (int e = 0; e < 8; ++e) y[e] = yv[e] + gg[e] * F.conv_w[(first ? 0 : 2 * D) + c0 + e] * pn_[e];
            *(u32x4*)(A2 + (size_t)t * (2 * D) + c0) = (u32x4){pk2(y[0], y[1]), pk2(y[2], y[3]), pk2(y[4], y[5]), pk2(y[6], y[7])};
        }
    }
}
__device__ __forceinline__ void p6_final(Frame& F) {
    const int gw = F.vcu * NWAVES + F.wave, NGW = F.G * NWAVES;
    const float* stats = (const float*)(F.ws + WS_STATS); const bf16_t* raw = (const bf16_t*)(F.ws + WS_RAW);
    const bf16_t* U = (const bf16_t*)(F.ws + WS_U); const float* rmsx = (const float*)(F.ws + WS_RMS);
    f32x4 gp[4], gi[4];
#pragma unroll
    for (int q = 0; q < 4; ++q) { gp[q] = *(const f32x4*)(F.g_post + 8 * F.lane + 512 * (q >> 1) + 4 * (q & 1)); const f32x4 g = *(const f32x4*)(F.g_pre + 8 * F.lane + 512 * (q >> 1) + 4 * (q & 1));
        gi[q] = (f32x4){1.f / g[0], 1.f / g[1], 1.f / g[2], 1.f / g[3]}; }
    for (int k = 0; k < M / NGW; ++k) {
        const int m = deal_row(k, gw, NGW);
        const f32x4 s0 = *(const f32x4*)(stats + (size_t)m * 16), s1 = *(const f32x4*)(stats + (size_t)m * 16 + 4), s2 = *(const f32x4*)(stats + (size_t)m * 16 + 8), s3 = *(const f32x4*)(stats + (size_t)m * 16 + 12);
        const float ss = ((s0[0] + s0[1]) + (s0[2] + s0[3])) + ((s1[0] + s1[1]) + (s1[2] + s1[3])) + ((s2[0] + s2[1]) + (s2[2] + s2[3])) + ((s3[0] + s3[1]) + (s3[2] + s3[3]));
        const float rstd = 1.0f / sqrtf(ss * (1.f / D) + EPS), rx = rmsx[m];
        float* orow = F.out + (size_t)m * D + 8 * F.lane; const bf16_t* rr = raw + (size_t)m * D + 8 * F.lane; const bf16_t* ur = U + (size_t)m * D + 8 * F.lane;
#pragma unroll
        for (int hf = 0; hf < 2; ++hf) {
            const u32x4 rw = __builtin_nontemporal_load((const u32x4*)(rr + 512 * hf)), uw = __builtin_nontemporal_load((const u32x4*)(ur + 512 * hf));
            const f32x4 r0 = {bflo(rw.x), bfhi(rw.x), bflo(rw.y), bfhi(rw.y)}, r1 = {bflo(rw.z), bfhi(rw.z), bflo(rw.w), bfhi(rw.w)};
            const f32x4 x0 = (f32x4){bflo(uw.x), bfhi(uw.x), bflo(uw.y), bfhi(uw.y)} * gi[2 * hf] * rx, x1 = (f32x4){bflo(uw.z), bfhi(uw.z), bflo(uw.w), bfhi(uw.w)} * gi[2 * hf + 1] * rx;
            __builtin_nontemporal_store(x0 + r0 * rstd * gp[2 * hf], (f32x4*)(orow + 512 * hf)); __builtin_nontemporal_store(x1 + r1 * rstd * gp[2 * hf + 1], (f32x4*)(orow + 512 * hf + 4));
        }
    }
}

__global__ void __launch_bounds__(NWAVES * 64, 2) fwd_kernel(Args args) {
    extern __shared__ __attribute__((aligned(16))) unsigned char lds_raw[];
    Frame F;
    F.lds = (LAS unsigned char*)lds_raw;
    F.tid = threadIdx.x; F.lane = F.tid & 63; F.wave = __builtin_amdgcn_readfirstlane(F.tid >> 6);
    F.G = gridDim.x; { const int bx = blockIdx.x; F.vcu = (F.G % 8 == 0) ? (bx % 8) * (F.G / 8) + bx / 8 : bx; }
    F.x = args.in[0]; F.meta = args.in[1]; F.g_pre = args.in[2]; F.w_in = args.in[3]; F.conv_w = args.in[4]; F.wgf = args.in[5]; F.bgf = args.in[6];
    F.wgb = args.in[7]; F.bgb = args.in[8]; F.gn = args.in[9]; F.w_oc = args.in[10]; F.w_og = args.in[11]; F.w_mo = args.in[12]; F.g_post = args.in[13];
    F.out = args.out; F.ws = args.ws;
    const int lo = args.ph_lo, hi = args.ph_hi;
#define IN(k) (lo <= (k) && (k) < hi)
    cg::grid_group grid = cg::this_grid();
    if (F.tid < 16) ((volatile LAS unsigned*)(F.lds + MISC_OFF))[F.tid] = 0u;
    __syncthreads();
    const XcdBarrier xbar = xcd_barrier_post((unsigned*)(args.ws + WS_CTL), (volatile LAS unsigned*)(F.lds + MISC_OFF));
#define SEAM(k) do { if (IN(k) && IN((k) + 1)) { if ((k) == 0) grid.sync(); else xcd_barrier(xbar); } } while (0)
    unsigned char* ws = args.ws; unsigned char* dob = (unsigned char*)args.out;
    if (IN(0)) { p0_prologue(F); }
    SEAM(0);
    if (IN(1)) {
        if (blockIdx.x < META_JOBS) meta_reduce(F, (int)blockIdx.x);
        pg8::Gemm g{(const bf16_t*)(ws + WS_U), (const bf16_t*)(ws + WS_WIN), M, NSLOT, D}; pg8::StaticOrder S; S.init(M, NSLOT, F.G, (int)blockIdx.x);
        for (int i = F.tid; i < NWAVES * CONV_STG_WAVE / 4; i += NWAVES * 64) ((LAS unsigned*)(F.lds + CONV_STG))[i] = 0u;
        __syncthreads();
        pg8::EpiProj E{(bf16_t*)(ws + WS_SIDEP), (bf16_t*)(ws + WS_SIDEG), (bf16_t*)(ws + WS_A2), (bf16_t*)(dob + DO_Q), (bf16_t*)(dob + DO_K), (bf16_t*)(ws + WS_V), (bf16_t*)(ws + WS_SA), (bf16_t*)(ws + WS_SB), (float*)(ws + WS_LR),
                       F.conv_w, F.lds + CONV_STG + F.wave * CONV_STG_WAVE};
        pg8::gemm_phase<pg8::EpiProj, pg8::StaticOrder>(F.lds, g, S, E);
    }
    SEAM(1);
    if (IN(2)) {
        conv_fixup(F);
        gla::Tensors X{(const bf16_t*)(dob + DO_Q), (const bf16_t*)(dob + DO_K), (const bf16_t*)(ws + WS_V), (const float*)(ws + WS_LR),
                       (const bf16_t*)(ws + WS_META + META_K), (const bf16_t*)(ws + WS_META + META_V), (const float*)(ws + WS_META + META_LR),
                       F.wgf, F.bgf, F.wgb, F.bgb, (bf16_t*)(dob + DO_OF), (bf16_t*)(ws + WS_OB), (bf16_t*)(ws + WS_A2), F.gn};
        { const int u = (int)blockIdx.x; gla::unit(F.lds, X, u >> 3, (u >> 1) & 3, u & 1, xbar); }
    }
    SEAM(2);
    if (IN(4)) {
        pg8::Gemm g{(const bf16_t*)(ws + WS_A2), (const bf16_t*)(ws + WS_WMG), M, D, 2 * D}; pg8::StaticOrder S; S.init(M, D, F.G, (int)blockIdx.x);
        pg8::EpiMerge E{(const bf16_t*)(ws + WS_SA), (const bf16_t*)(ws + WS_SB), (bf16_t*)(ws + WS_MERGED)};
        pg8::gemm_phase<pg8::EpiMerge, pg8::StaticOrder>(F.lds, g, S, E);
    }
    SEAM(4);
    if (IN(5)) {
        pg8::Gemm g{(const bf16_t*)(ws + WS_MERGED), (const bf16_t*)(ws + WS_WOUT), M, D, D}; pg8::StaticOrder S; S.init(M, D, F.G, (int)blockIdx.x);
        pg8::EpiOut E{(bf16_t*)(ws + WS_RAW), (float*)(ws + WS_STATS)};
        pg8::gemm_phase<pg8::EpiOut, pg8::StaticOrder>(F.lds, g, S, E);
    }
    SEAM(5);
    if (IN(6)) { p6_final(F); }
#undef IN
#undef SEAM
}

extern "C" void kernel_launch(void* const* d_in, const int* in_sizes, int n_in, void* d_out, int out_size, void* d_ws, size_t ws_size, hipStream_t stream) {
    static int grid = 0;
    if (grid == 0) {
        if (n_in != 14 || in_sizes[0] != M * D || out_size != M * D || ws_size < WS_END) {
            fprintf(stderr, "kernel_launch: unexpected shapes (n_in %d, in0 %d, out %d, ws %zu; need ws >= %zu); nothing launched\n", n_in, n_in > 0 ? in_sizes[0] : -1, out_size, ws_size, (size_t)WS_END); grid = -1; return; }
        int dev = 0, cus = 0, per_cu = 0;
        if (hipGetDevice(&dev) != hipSuccess || hipDeviceGetAttribute(&cus, hipDeviceAttributeMultiprocessorCount, dev) != hipSuccess) { grid = -1; return; }
        if (hipFuncSetAttribute((const void*)fwd_kernel, hipFuncAttributeMaxDynamicSharedMemorySize, LDS_BYTES) != hipSuccess) { fprintf(stderr, "kernel_launch: hipFuncSetAttribute failed\n"); grid = -1; return; }
        if (hipOccupancyMaxActiveBlocksPerMultiprocessor(&per_cu, (const void*)fwd_kernel, NWAVES * 64, LDS_BYTES) != hipSuccess || per_cu < 1) { fprintf(stderr, "kernel_launch: occupancy query says %d blocks per CU\n", per_cu); per_cu = 1; }
        (void)hipGetLastError();
        grid = cus;
        if (grid != NB * NH * 2) { fprintf(stderr, "kernel_launch: this kernel needs exactly %d workgroups (one GLA unit each); the device has %d CUs; nothing launched\n", NB * NH * 2, cus); grid = -1; return; }
    }
    if (grid < 0) return;
    Args a{};
    for (int i = 0; i < 14; ++i) a.in[i] = (const float*)d_in[i];
    a.out = (float*)d_out; a.ws = (unsigned char*)d_ws;
    if (hipMemsetAsync((char*)d_ws + WS_CTL, 0, CTL_BYTES, stream) != hipSuccess) { fprintf(stderr, "kernel_launch: memset of the barrier words failed\n"); return; }
    a.ph_lo = 0; a.ph_hi = 7;
    void* params[] = {&a};
    hipError_t e = hipLaunchCooperativeKernel((const void*)fwd_kernel, dim3(grid), dim3(NWAVES * 64), params, LDS_BYTES, stream);
    if (e != hipSuccess) fprintf(stderr, "kernel_launch: cooperative launch failed: %s (grid %d)\n", hipGetErrorString(e), grid);
}
```

```cpp
#include <hip/hip_runtime.h>
#include <hip/hip_cooperative_groups.h>
#include <cstdio>
#include <cstdint>
namespace cg = cooperative_groups;

#define LAS __attribute__((address_space(3)))
typedef unsigned short bf16_t;
typedef short bf16x8 __attribute__((ext_vector_type(8)));
typedef short s16x4 __attribute__((ext_vector_type(4)));
typedef float f32x4 __attribute__((ext_vector_type(4)));
typedef float f32x2 __attribute__((ext_vector_type(2)));
typedef float f32x16 __attribute__((ext_vector_type(16)));
typedef unsigned u32x4 __attribute__((ext_vector_type(4)));
typedef unsigned u32x2 __attribute__((ext_vector_type(2)));
typedef __bf16 bf2_t __attribute__((ext_vector_type(2)));

__device__ __forceinline__ unsigned pk2(float lo, float hi) { f32x2 v = {lo, hi}; bf2_t b = __builtin_convertvector(v, bf2_t); return __builtin_bit_cast(unsigned, b); }
__device__ __forceinline__ float bflo(unsigned w) { return __builtin_bit_cast(float, w << 16); }
__device__ __forceinline__ float bfhi(unsigned w) { return __builtin_bit_cast(float, w & 0xffff0000u); }
__device__ __forceinline__ float sigm(float x) { return __builtin_amdgcn_rcpf(1.f + __expf(-x)); }
template <int CTRL> __device__ __forceinline__ float dpp_mov(float v) { return __builtin_bit_cast(float, __builtin_amdgcn_update_dpp(0, __builtin_bit_cast(int, v), CTRL, 0xF, 0xF, true)); }
__device__ __forceinline__ float row16_sum(float v) { v += dpp_mov<0xB1>(v); v += dpp_mov<0x4E>(v); v += dpp_mov<0x141>(v); v += dpp_mov<0x140>(v); return v; }
__device__ __forceinline__ void swap16(unsigned& a, unsigned& b) { asm volatile("s_nop 1\n\tv_permlane16_swap_b32 %0, %1" : "+v"(a), "+v"(b)); }
__device__ __forceinline__ void swap32(unsigned& a, unsigned& b) { asm volatile("s_nop 1\n\tv_permlane32_swap_b32 %0, %1" : "+v"(a), "+v"(b)); }
__device__ __forceinline__ float sum_x16(float v) { unsigned a = __builtin_bit_cast(unsigned, v), b = a; swap16(a, b); return __builtin_bit_cast(float, a) + __builtin_bit_cast(float, b); }
__device__ __forceinline__ float sum_x32(float v) { unsigned a = __builtin_bit_cast(unsigned, v), b = a; swap32(a, b); return __builtin_bit_cast(float, a) + __builtin_bit_cast(float, b); }
__device__ __forceinline__ float get_x32(float v, int hi) { unsigned a = __builtin_bit_cast(unsigned, v), b = a; swap32(a, b); return __builtin_bit_cast(float, hi ? a : b); }
#define LDS_WAIT() asm volatile("s_waitcnt lgkmcnt(0)" ::: "memory")
#define LBAR() do { asm volatile("s_waitcnt lgkmcnt(0)" ::: "memory"); __builtin_amdgcn_s_barrier(); asm volatile("" ::: "memory"); } while (0)

typedef __amdgpu_buffer_rsrc_t rsrc_t;
typedef unsigned v4u_t __attribute__((__vector_size__(16)));
__device__ __forceinline__ rsrc_t mk_rsrc(const void* p, unsigned bytes) { return __builtin_amdgcn_make_buffer_rsrc((void*)p, (short)0, (int)bytes, 0x00020000); }
__device__ __forceinline__ u32x4 bld128(rsrc_t r, unsigned voff, unsigned soff) { return __builtin_bit_cast(u32x4, __builtin_amdgcn_raw_buffer_load_b128(r, (int)voff, (int)soff, 0)); }
__device__ __forceinline__ void bst128(u32x4 v, rsrc_t r, unsigned voff, unsigned soff) { __builtin_amdgcn_raw_buffer_store_b128(__builtin_bit_cast(v4u_t, v), r, (int)voff, (int)soff, 0); }

constexpr int NB = 32, T = 2048, D = 1024, M = NB * T;
constexpr int NIN = 9248, NSLOT = 9472;
constexpr int NH = 4, DK = 128, DV = 256, CH = 64;
constexpr float EPS = 1e-6f;
constexpr int O_CB = 0, O_CC = 1024, O_CX = 2048, O_CZ = 3072, O_Q = 4096, O_K = 4608, O_V = 5120, O_R = 6144, O_LRF = 7168, O_LRB = 7184, O_MA = 7200, O_MB = 8224;

__device__ __forceinline__ size_t a2_off(int row, int col) { return ((size_t)((row >> 8) * 32 + (col >> 6)) * 256 + (size_t)(row & 255)) * 64 + (size_t)(col & 63); }
constexpr size_t MiB = 1u << 20;
constexpr size_t WS_WIN = 1 * MiB, WS_WMG = 20 * MiB, WS_WOUT = 24 * MiB, WS_META = 26 * MiB, WS_LR = 27 * MiB, WS_STATS = 35 * MiB;
constexpr size_t WS_P = 64 * MiB, WS_A2 = 192 * MiB, WS_V = 448 * MiB, WS_SA = 576 * MiB, WS_SB = 704 * MiB, WS_OB = 832 * MiB, WS_END = 960 * MiB;
constexpr size_t WS_SIDEP = 40 * MiB, WS_SIDEG = 44 * MiB;
constexpr size_t WS_MERGED = WS_OB;
constexpr size_t WS_U = WS_P, WS_RMS = 52 * MiB;
constexpr size_t WS_RAW = WS_V;
constexpr size_t META_K = 0, META_V = 65536, META_LR = 65536 + 131072, META_CC = META_LR + 8192, META_CX = META_CC + 4096;
constexpr size_t DO_U = 0, DO_OF = 0, DO_Q = 128 * MiB, DO_K = 192 * MiB;

typedef unsigned v2u_t __attribute__((__vector_size__(8)));
__device__ __forceinline__ void bst64_wt(u32x2 v, rsrc_t r, unsigned voff, unsigned soff) { __builtin_amdgcn_raw_buffer_store_b64(__builtin_bit_cast(v2u_t, v), r, (int)voff, (int)soff, 17); }
__device__ __forceinline__ void u_rows8(const float* x, const float* g_pre, unsigned short* U, float* rmsx, unsigned* ready, int m0, int lane) {
    constexpr int Dd = 1024;
    const float* xr = x + (size_t)m0 * Dd + 4 * lane;
    f32x4 v[8][4];
#pragma unroll
    for (int r = 0; r < 8; ++r)
#pragma unroll
        for (int q = 0; q < 4; ++q) v[r][q] = __builtin_nontemporal_load((const f32x4*)(xr + r * Dd + 256 * q));
    f32x4 gp[4];
#pragma unroll
    for (int q = 0; q < 4; ++q) gp[q] = *(const f32x4*)(g_pre + 4 * lane + 256 * q);
    const rsrc_t ru = mk_rsrc(U, (unsigned)((size_t)65536 * Dd * 2));
#pragma unroll
    for (int r = 0; r < 8; ++r) {
        float s = 0.f;
#pragma unroll
        for (int q = 0; q < 4; ++q) s += (v[r][q][0] * v[r][q][0] + v[r][q][1] * v[r][q][1]) + (v[r][q][2] * v[r][q][2] + v[r][q][3] * v[r][q][3]);
        const float ms = sum_x32(sum_x16(row16_sum(s))) * (1.f / Dd) + 1e-6f;
        const float rstd = __builtin_amdgcn_rsqf(ms);
        if (lane == 0) rmsx[m0 + r] = ms * rstd;
#pragma unroll
        for (int q = 0; q < 4; ++q) { const f32x4 y = v[r][q] * rstd * gp[q];
            bst64_wt((u32x2){pk2(y[0], y[1]), pk2(y[2], y[3])}, ru, (unsigned)(8 * lane + 512 * q), (unsigned)((m0 + r) * (Dd * 2))); }
    }
    asm volatile("s_waitcnt vmcnt(0)" ::: "memory");
    if (lane == 0) (void)__hip_atomic_fetch_add(ready, 1u, __ATOMIC_RELAXED, __HIP_MEMORY_SCOPE_AGENT);
}

namespace pg8 {
constexpr int BM = 256, BK = 64, HALF = 128, HTB = HALF * BK * 2, STAGE_BYTES = 8 * HTB, NXCD = 8, WGM = 8;
__host__ __device__ __forceinline__ int lds_byte(int r, int c) { const int st = (r >> 4) * 2 + (c >> 5), rr = r & 15, cc = c & 31, ob = rr * 64 + cc * 2; return st * 1024 + (ob ^ (((ob >> 9) & 1) << 5)); }
__host__ __device__ __forceinline__ void stage_rc(int b, int& R, int& C) { const int st = b / 1024, sb = b % 1024, swz = sb ^ (((sb >> 9) & 1) << 5); R = (st >> 1) * 16 + swz / 64; C = (st & 1) * 32 + (swz % 64) / 2; }
struct Unit { int pm, pn; };
struct Gemm { const bf16_t* A; const bf16_t* Bt; int M, N, K; int a_blocked; };
struct StaticOrder {
    int nM, nN, nwg, G, c, rev = 0;
    __host__ __device__ void init(int M_, int N_, int G_, int c_) { nM = M_ / BM; nN = N_ / BM; nwg = nM * nN; G = G_; c = c_; }
    __host__ __device__ bool next(int i, Unit& u) const {
        if (rev) { const int R = nwg / G; if (i >= R) return false; i = R - 1 - i; }
        const long L = (long)i * G + c; if (L >= nwg) return false;
        int wgid = (int)L; { const int q = nwg / NXCD, r = nwg % NXCD, xcd = wgid % NXCD, off = wgid / NXCD; wgid = (xcd < r ? xcd * (q + 1) : r * (q + 1) + (xcd - r) * q) + off; }
        const int nig = WGM * nN, gid = wgid / nig, fm = gid * WGM, gsz = (nM - fm) < WGM ? (nM - fm) : WGM;
        u.pm = fm + ((wgid % nig) % gsz); u.pn = (wgid % nig) / gsz; return true;
    }
    static constexpr bool SLICED = false; static constexpr int NSTAT = 1 << 30;
    __device__ __forceinline__ void a_ready(int) const {}
    __device__ __forceinline__ void after_unit(int, int, int) const {}
};
struct SlicedOrder : StaticOrder {
    static constexpr bool SLICED = true;
    static constexpr int NSTAT = 34, NDYN = 768;
    const float* x; const float* g_pre; unsigned short* U; float* rmsx; unsigned* ready; unsigned* queue; volatile LAS int* slot; unsigned* nunits;
    __device__ bool next(int i, Unit& u) const {
        if (i < NSTAT) return StaticOrder::next(i, u);
        const int d = slot[i & 3]; if (d >= NDYN) return false;
        const int wgid = (d & 7) * 1184 + 1088 + (d >> 3), w296 = wgid % 296;
        u.pm = (wgid / 296) * 8 + (w296 & 7); u.pn = w296 >> 3; return true;
    }
    __device__ __forceinline__ void a_ready(int g) const { a_ready_x(c & 7, g); }
    __device__ __forceinline__ void a_ready_x(int xq, int g) const {
        if (threadIdx.x < 64) {
            const unsigned* p = ready + 64 * (4 * xq + g);
            unsigned polls = 0;
            while ((unsigned)__builtin_amdgcn_readfirstlane(__hip_atomic_load(p, __ATOMIC_RELAXED, __HIP_MEMORY_SCOPE_AGENT)) < 256u) { __builtin_amdgcn_s_sleep(2); if (++polls > (1u << 22)) break; }
            __builtin_amdgcn_fence(__ATOMIC_ACQUIRE, "agent");
            asm volatile("s_waitcnt vmcnt(0)" ::: "memory");
        }
        asm volatile("" ::: "memory"); __builtin_amdgcn_s_barrier(); asm volatile("" ::: "memory");
    }
    __device__ __forceinline__ void after_unit(int ui, int wid, int lane) const {
        const int s = ui - ((c >> 3) & 7);
        if (s == 0 || s == 9 || s == 18) {
            const int g = s / 9 + 1, xq = c & 7, j = c >> 3;
            u_rows8(x, g_pre, U, rmsx, ready + 64 * (4 * xq + g), (32 * xq + 8 * g) * 256 + 64 * j + 8 * wid, lane);
        }
    }
};

__device__ __forceinline__ float sig_fast(float x) { return __builtin_amdgcn_rcpf(1.f + __builtin_amdgcn_exp2f(-1.4426950408889634f * x)); }
struct EpiProj {
    static constexpr bool AFTER_DRAIN = false, MID = false;
    bf16_t *SIDEP, *SIDEG, *A2, *Q, *K, *V, *RA, *SB; float* LR; const float* convw; LAS unsigned char* stage;
    __device__ __forceinline__ void mid(f32x4 (&)[2][2][4][2], const Unit&, int, int, int, int) const {}
    __device__ __forceinline__ void plain(const f32x4 (&acc)[2][2][4][2], bf16_t* base, int ld, int row0, int col0, float scale) const {
#pragma unroll
        for (int ai = 0; ai < 2; ++ai)
#pragma unroll
            for (int m = 0; m < 4; ++m) {
                bf16_t* rowp = base + (size_t)(row0 + ai * HALF + m * 16) * ld + col0;
#pragma unroll
                for (int bj = 0; bj < 2; ++bj) {
                    const f32x4 v0 = acc[ai][bj][m][0] * scale, v1 = acc[ai][bj][m][1] * scale;
                    *(u32x4*)(rowp + bj * HALF) = (u32x4){pk2(v0[0], v0[1]), pk2(v0[2], v0[3]), pk2(v1[0], v1[1]), pk2(v1[2], v1[3])};
                }
            }
    }
    __device__ __forceinline__ void operator()(const f32x4 (&acc)[2][2][4][2], const Unit& u, int wr, int wc, int fr, int fq) const {
        const int row0 = u.pm * BM + wr * 64 + fr; const int pn = u.pn;
        if (pn < 16) {
            const int ch0 = pn * 64 + wc * 16 + fq * 4;
            const f32x4 w0 = *(const f32x4*)(convw + ch0), w1 = *(const f32x4*)(convw + D + ch0), w2 = *(const f32x4*)(convw + 2 * D + ch0);
            LAS unsigned char* stg = stage + (fr + 1) * 32 + fq * 8;
#pragma unroll
            for (int ai = 0; ai < 2; ++ai) {
                f32x4 p[4], g[4];
#pragma unroll
                for (int m = 0; m < 4; ++m) {
                    const f32x4 cb = acc[ai][0][m][0], cc = acc[ai][0][m][1], cx = acc[ai][1][m][0], cz = acc[ai][1][m][1];
                    p[m] = cc * cx; g[m] = cb * cz;
#pragma unroll
                    for (int e = 0; e < 4; ++e) g[m][e] *= sig_fast(cz[e]);
                    *(LAS u32x2*)(stg + m * 512) = (u32x2){pk2(p[m][0], p[m][1]), pk2(p[m][2], p[m][3])};
                }
                asm volatile("s_waitcnt lgkmcnt(0)" ::: "memory");
                const int run = u.pm * 4 + ai * 2 + wr;
#pragma unroll
                for (int m = 0; m < 4; ++m) {
                    const size_t row = (size_t)(row0 + ai * HALF + m * 16);
                    const u32x2 a = *(const LAS u32x2*)(stg + m * 512 - 32), b = *(const LAS u32x2*)(stg + m * 512 + 32);
                    const f32x4 pm = {bflo(a.x), bfhi(a.x), bflo(a.y), bfhi(a.y)}, pp = {bflo(b.x), bfhi(b.x), bflo(b.y), bfhi(b.y)};
                    const f32x4 y = g[m] * (w0 * pm + w1 * p[m] + w2 * pp);
                    *(u32x2*)(A2 + a2_off((int)row, ch0)) = (u32x2){pk2(y[0], y[1]), pk2(y[2], y[3])};
                    if ((m == 0 && fr == 0) || (m == 3 && fr == 15)) {
                        const size_t so = ((size_t)run * 2 + (m == 3 ? 1 : 0)) * D + ch0;
                        *(u32x2*)(SIDEP + so) = (u32x2){pk2(p[m][0], p[m][1]), pk2(p[m][2], p[m][3])};
                        *(u32x2*)(SIDEG + so) = (u32x2){pk2(g[m][0], g[m][1]), pk2(g[m][2], g[m][3])};
                    }
                }
                asm volatile("" ::: "memory");
            }
        } else if (pn < 24) {
            const int col0 = wc * 32 + fq * 8;
            if (pn < 18)      plain(acc, Q, 512, row0, (pn - 16) * 256 + col0, 0.08838834764831845f);
            else if (pn < 20) plain(acc, K, 512, row0, (pn - 18) * 256 + col0, 1.f);
            else              plain(acc, V, D, row0, (pn - 20) * 256 + col0, 1.f);
        } else if (pn < 28) {
#pragma unroll
            for (int ai = 0; ai < 2; ++ai)
#pragma unroll
                for (int m = 0; m < 4; ++m)
#pragma unroll
                    for (int bj = 0; bj < 2; ++bj) {
                        const f32x4 v0 = acc[ai][bj][m][0], v1 = acc[ai][bj][m][1];
                        *(u32x4*)(A2 + a2_off(row0 + ai * HALF + m * 16, D + (pn - 24) * 256 + bj * HALF + wc * 32 + fq * 8)) = (u32x4){pk2(v0[0], v0[1]), pk2(v0[2], v0[3]), pk2(v1[0], v1[1]), pk2(v1[2], v1[3])};
                    }
        } else if (pn < 36) {
            const int col0 = (pn - 28) * 128 + wc * 32 + fq * 8;
#pragma unroll
            for (int ai = 0; ai < 2; ++ai)
#pragma unroll
                for (int m = 0; m < 4; ++m) {
                    const size_t off = ((size_t)(u.pm * 8 + (pn - 28)) * 256 + (size_t)((row0 + ai * HALF + m * 16) & 255)) * 128 + (size_t)(wc * 32 + fq * 8);
                    float ra[8], sb[8];
#pragma unroll
                    for (int n = 0; n < 2; ++n)
#pragma unroll
                        for (int e = 0; e < 4; ++e) {
                            const float ea = 1.f + __builtin_amdgcn_exp2f(-1.4426950408889634f * acc[ai][0][m][n][e]), eb = 1.f + __builtin_amdgcn_exp2f(-1.4426950408889634f * acc[ai][1][m][n][e]);
                            ra[4 * n + e] = eb * __builtin_amdgcn_rcpf(ea); sb[4 * n + e] = __builtin_amdgcn_rcpf(eb);
                        }
                    *(u32x4*)(RA + off) = (u32x4){pk2(ra[0], ra[1]), pk2(ra[2], ra[3]), pk2(ra[4], ra[5]), pk2(ra[6], ra[7])};
                    *(u32x4*)(SB + off) = (u32x4){pk2(sb[0], sb[1]), pk2(sb[2], sb[3]), pk2(sb[4], sb[5]), pk2(sb[6], sb[7])};
                }
        } else {
            if (wc == 0) {
#pragma unroll
                for (int ai = 0; ai < 2; ++ai)
#pragma unroll
                    for (int m = 0; m < 4; ++m) {
                        float* rowp = LR + (size_t)(row0 + ai * HALF + m * 16) * 32 + 4 * fq;
                        *(f32x4*)(rowp) = acc[ai][0][m][0]; *(f32x4*)(rowp + 16) = acc[ai][0][m][1];
                    }
            }
        }
    }
};
struct EpiMerge {
    static constexpr bool AFTER_DRAIN = false, MID = true;
    const bf16_t *SA, *SB; bf16_t* O;
    __device__ __forceinline__ void mid(f32x4 (&acc)[2][2][4][2], const Unit& u, int wr, int wc, int fr, int fq) const {
        const rsrc_t ra = mk_rsrc(SA, (unsigned)((size_t)M * D * 2));
        const unsigned voff = (unsigned)((wr * 64 + fr) * 128 + wc * 32 + fq * 8) * 2u;
        const unsigned uoff = (unsigned)((u.pm * 8 + u.pn * 2) * 256 * 128) * 2u;
        u32x4 gv[2][4][2];
#pragma unroll
        for (int ai = 0; ai < 2; ++ai)
#pragma unroll
            for (int m = 0; m < 4; ++m)
#pragma unroll
                for (int bj = 0; bj < 2; ++bj) gv[ai][m][bj] = bld128(ra, voff, uoff + (unsigned)((bj * 256 + ai * HALF + m * 16) * 128) * 2u);
        __builtin_amdgcn_sched_barrier(0);
#pragma unroll
        for (int ai = 0; ai < 2; ++ai)
#pragma unroll
            for (int m = 0; m < 4; ++m)
#pragma unroll
                for (int bj = 0; bj < 2; ++bj) {
                    const u32x4 a = gv[ai][m][bj];
                    acc[ai][bj][m][0] *= (f32x4){bflo(a.x), bfhi(a.x), bflo(a.y), bfhi(a.y)}; acc[ai][bj][m][1] *= (f32x4){bflo(a.z), bfhi(a.z), bflo(a.w), bfhi(a.w)};
                }
    }
    __device__ __forceinline__ void operator()(const f32x4 (&acc)[2][2][4][2], const Unit& u, int wr, int wc, int fr, int fq) const {
        const rsrc_t rb = mk_rsrc(SB, (unsigned)((size_t)M * D * 2)), ro = mk_rsrc(O, (unsigned)((size_t)M * D * 2));
        const unsigned voff = (unsigned)((wr * 64 + fr) * 128 + wc * 32 + fq * 8) * 2u;
        const unsigned uoff = (unsigned)((u.pm * 8 + u.pn * 2) * 256 * 128) * 2u;
        const unsigned voffo = (unsigned)((wr * 64 + fr) * 64 + (wc & 1) * 32 + fq * 8) * 2u;
        const unsigned uoffo = (unsigned)(((u.pm * 16 + u.pn * 4 + (wc >> 1)) * 256) * 64) * 2u;
        u32x4 gv[2][4][2];
#pragma unroll
        for (int ai = 0; ai < 2; ++ai)
#pragma unroll
            for (int m = 0; m < 4; ++m)
#pragma unroll
                for (int bj = 0; bj < 2; ++bj) gv[ai][m][bj] = bld128(rb, voff, uoff + (unsigned)((bj * 256 + ai * HALF + m * 16) * 128) * 2u);
        __builtin_amdgcn_sched_barrier(0);
#pragma unroll
        for (int ai = 0; ai < 2; ++ai)
#pragma unroll
            for (int m = 0; m < 4; ++m)
#pragma unroll
                for (int bj = 0; bj < 2; ++bj) {
                    const u32x4 b = gv[ai][m][bj];
                    const f32x4 v0 = acc[ai][bj][m][0], v1 = acc[ai][bj][m][1];
                    u32x4 w;
                    w.x = pk2(v0[0] * bflo(b.x), v0[1] * bfhi(b.x)); w.y = pk2(v0[2] * bflo(b.y), v0[3] * bfhi(b.y));
                    w.z = pk2(v1[0] * bflo(b.z), v1[1] * bfhi(b.z)); w.w = pk2(v1[2] * bflo(b.w), v1[3] * bfhi(b.w));
                    bst128(w, ro, voffo, uoffo + (unsigned)(((bj * 2) * 256 * 64 + (ai * HALF + m * 16) * 64) * 2));
                }
    }
};
struct EpiOut {
    static constexpr bool AFTER_DRAIN = false, MID = false;
    bf16_t* C; float* stats;
    __device__ __forceinline__ void mid(f32x4 (&)[2][2][4][2], const Unit&, int, int, int, int) const {}
    __device__ __forceinline__ void operator()(const f32x4 (&acc)[2][2][4][2], const Unit& u, int wr, int wc, int fr, int fq) const {
        const int row0 = u.pm * BM + wr * 64 + fr, col0 = u.pn * BM + wc * 32 + 8 * fq;
#pragma unroll
        for (int ai = 0; ai < 2; ++ai)
#pragma unroll
            for (int m = 0; m < 4; ++m) {
                const size_t row = (size_t)(row0 + ai * HALF + m * 16);
                bf16_t* rowp = C + row * D + col0; float s = 0.f;
#pragma unroll
                for (int bj = 0; bj < 2; ++bj) {
                    const f32x4 v0 = acc[ai][bj][m][0], v1 = acc[ai][bj][m][1];
                    s += ((v0[0] * v0[0] + v0[1] * v0[1]) + (v0[2] * v0[2] + v0[3] * v0[3])) + ((v1[0] * v1[0] + v1[1] * v1[1]) + (v1[2] * v1[2] + v1[3] * v1[3]));
                    *(u32x4*)(rowp + bj * HALF) = (u32x4){pk2(v0[0], v0[1]), pk2(v0[2], v0[3]), pk2(v1[0], v1[1]), pk2(v1[2], v1[3])};
                }
                s = sum_x32(sum_x16(s));
                if (fq == 0) stats[row * 16 + u.pn * 4 + wc] = s;
            }
    }
};

template <class Epi, class Sched>
__device__ __forceinline__ void gemm_phase(LAS unsigned char* lds, const Gemm g, const Sched& S, const Epi& E) {
    const int tid = threadIdx.x, wid = __builtin_amdgcn_readfirstlane(tid >> 6), lane = tid & 63, wr = wid >> 2, wc = wid & 3, fr = lane & 15, fq = lane >> 4;
    const int K = g.K, nt = K / BK;
    const int lda = g.a_blocked ? BK : K;
    unsigned voffA[2], voffB[2];
#pragma unroll
    for (int i = 0; i < 2; ++i) { int R, C; stage_rc(tid * 16 + i * 8192, R, C); voffA[i] = (unsigned)(R * lda + C) * 2u; voffB[i] = (unsigned)(R * K + C) * 2u; }
    const size_t kstep = (size_t)(BK * 2), kstepA = g.a_blocked ? (size_t)(BM * BK * 2) : kstep;
    const size_t hstep = (size_t)HALF * K * 2, hstepA = (size_t)HALF * lda * 2;
    const size_t tstep = 2 * hstep;
    const unsigned ldsw = (unsigned)wid * 1024u;
    const int aoff = lds_byte(wr * 64 + fr, fq * 8), boff = lds_byte(wc * 32 + fr, fq * 8);
#define PG8_SA(b, h) (((b) * 2 + (h)) * HTB)
#define PG8_SB(b, h) ((4 + (b) * 2 + (h)) * HTB)
#define PG8_STAGE_A(bufoff, gbase) do { _Pragma("unroll") for (int _i = 0; _i < 2; ++_i) \
        __builtin_amdgcn_global_load_lds((const unsigned*)((const char*)(gbase) + voffA[_i]), (LAS unsigned*)(lds + (bufoff) + ldsw + _i * 8192), 16, 0, 0); } while (0)
#define PG8_STAGE(bufoff, gbase) do { _Pragma("unroll") for (int _i = 0; _i < 2; ++_i) \
        __builtin_amdgcn_global_load_lds((const unsigned*)((const char*)(gbase) + voffB[_i]), (LAS unsigned*)(lds + (bufoff) + ldsw + _i * 8192), 16, 0, 0); } while (0)
#define PG8_LDA(dst, b, h) do { _Pragma("unroll") for (int m = 0; m < 4; ++m) _Pragma("unroll") for (int k = 0; k < 2; ++k) dst[m][k] = *(const LAS bf16x8*)(lds + PG8_SA(b, h) + aoff + m * 2048 + k * 1024); } while (0)
#define PG8_LDB(dst, b, h) do { _Pragma("unroll") for (int n = 0; n < 2; ++n) _Pragma("unroll") for (int k = 0; k < 2; ++k) dst[n][k] = *(const LAS bf16x8*)(lds + PG8_SB(b, h) + boff + n * 2048 + k * 1024); } while (0)
#define PG8_MMA(ai, bj, At, Bt) do { __builtin_amdgcn_s_setprio(1); _Pragma("unroll") for (int m = 0; m < 4; ++m) _Pragma("unroll") for (int n = 0; n < 2; ++n) _Pragma("unroll") for (int k = 0; k < 2; ++k) \
        acc[ai][bj][m][n] = __builtin_amdgcn_mfma_f32_16x16x32_bf16(Bt[n][k], At[m][k], acc[ai][bj][m][n], 0, 0, 0); __builtin_amdgcn_s_setprio(0); } while (0)
#define PG8_WAIT_V(n) asm volatile("s_waitcnt vmcnt(" #n ")" ::: "memory")
#define PG8_WAIT_L(n) asm volatile("s_waitcnt lgkmcnt(" #n ")" ::: "memory")
#define PG8_BAR __builtin_amdgcn_s_barrier()
#define PG8_SCHED __builtin_amdgcn_sched_barrier(0)
    Unit cur, nxt; int ui = 0; int acquired = 0, facq = 0, dq = 0;
    if (!S.next(0, cur)) return;
    f32x4 acc[2][2][4][2];
#pragma unroll
    for (int a = 0; a < 2; ++a)
#pragma unroll
        for (int b = 0; b < 2; ++b)
#pragma unroll
            for (int m = 0; m < 4; ++m)
#pragma unroll
                for (int n = 0; n < 2; ++n) acc[a][b][m][n] = (f32x4){0.f, 0.f, 0.f, 0.f};
    bf16x8 At[4][2], B0[2][2], B1[2][2];
    const char* cA = (const char*)g.A + (size_t)cur.pm * tstep; const char* cB = (const char*)g.Bt + (size_t)cur.pn * tstep;
    PG8_STAGE(PG8_SB(0, 0), cB); PG8_STAGE(PG8_SB(0, 1), cB + hstep); PG8_STAGE_A(PG8_SA(0, 0), cA); PG8_STAGE_A(PG8_SA(0, 1), cA + hstepA);
    if (wr == 1) PG8_BAR;
    PG8_WAIT_V(2); PG8_BAR;
    PG8_STAGE(PG8_SB(1, 0), cB + kstep); PG8_STAGE_A(PG8_SA(1, 0), cA + kstepA); PG8_STAGE(PG8_SB(1, 1), cB + hstep + kstep);
    PG8_WAIT_V(6); PG8_BAR;
    for (;;) {
        const bool has_next = S.next(ui + 1, nxt);
        const char* nA = has_next ? (const char*)g.A + (size_t)nxt.pm * tstep : cA; const char* nB = has_next ? (const char*)g.Bt + (size_t)nxt.pn * tstep : cB;
        for (int part = 0; part < (Epi::MID ? 2 : 1); ++part) {
        const int t_lo = part ? (nt >> 1) : 0, t_hi = (Epi::MID && part == 0) ? (nt >> 1) : nt;
        if constexpr (Epi::MID) { if (part == 1) E.mid(acc, cur, wr, wc, fr, fq); }
        for (int t = t_lo; t < t_hi; t += 2) {
            const bool last = (t == nt - 2);
            if constexpr (Sched::SLICED) { if (last && has_next) {
                const int nx_ = nxt.pm >> 5, ng = (nxt.pm & 31) >> 3;
                if (nx_ == (S.c & 7)) { if (ng > acquired) { S.a_ready(ng); acquired = ng; } }
                else if (!((facq >> nx_) & 1)) { S.a_ready_x(nx_, ng); facq |= 1 << nx_; }
            }
            if (last && ui + 3 >= Sched::NSTAT && tid == 0) dq = (int)__hip_atomic_fetch_add(S.queue, 1u, __ATOMIC_RELAXED, __HIP_MEMORY_SCOPE_AGENT); }
            const char* a1 = cA + (size_t)(t + 1) * kstepA;
            const char* a2 = last ? nA : cA + (size_t)(t + 2) * kstepA; const char* b2 = last ? nB : cB + (size_t)(t + 2) * kstep;
            const char* a3 = a2 + kstepA; const char* b3 = b2 + kstep;
            PG8_LDB(B0, 0, 0); PG8_LDB(B1, 0, 1); PG8_SCHED; PG8_LDA(At, 0, 0); PG8_STAGE_A(PG8_SA(1, 1), a1 + hstepA);
            PG8_WAIT_V(8); PG8_WAIT_L(0); PG8_BAR; PG8_MMA(0, 0, At, B0); PG8_MMA(0, 1, At, B1); PG8_BAR; PG8_SCHED;
            PG8_LDA(At, 0, 1); PG8_STAGE(PG8_SB(0, 0), b2); PG8_STAGE(PG8_SB(0, 1), b2 + hstep); PG8_STAGE_A(PG8_SA(0, 0), a2);
            PG8_WAIT_V(8); PG8_WAIT_L(0); PG8_BAR; PG8_MMA(1, 0, At, B0); PG8_MMA(1, 1, At, B1); PG8_BAR; PG8_SCHED;
            PG8_LDB(B0, 1, 0); PG8_LDB(B1, 1, 1); PG8_SCHED; PG8_LDA(At, 1, 0); PG8_STAGE_A(PG8_SA(0, 1), a2 + hstepA);
            PG8_WAIT_V(8); PG8_WAIT_L(0); PG8_BAR; PG8_MMA(0, 0, At, B0); PG8_MMA(0, 1, At, B1); PG8_BAR; PG8_SCHED;
            PG8_LDA(At, 1, 1); PG8_STAGE(PG8_SB(1, 0), b3); PG8_STAGE(PG8_SB(1, 1), b3 + hstep); PG8_STAGE_A(PG8_SA(1, 0), a3);
            PG8_WAIT_V(8); PG8_WAIT_L(0); PG8_BAR; PG8_MMA(1, 0, At, B0); PG8_MMA(1, 1, At, B1); PG8_BAR; PG8_SCHED;
        }
        }
        if constexpr (Sched::SLICED) { if (ui + 3 >= Sched::NSTAT && tid == 0) S.slot[(ui + 3) & 3] = dq; }
        if (wr == 0) PG8_BAR;
        E(acc, cur, wr, wc, fr, fq);
        if (!has_next) break;
        if constexpr (Sched::SLICED) S.after_unit(ui, wid, lane);
#pragma unroll
        for (int a = 0; a < 2; ++a)
#pragma unroll
            for (int b = 0; b < 2; ++b)
#pragma unroll
                for (int m = 0; m < 4; ++m)
#pragma unroll
                    for (int n = 0; n < 2; ++n) acc[a][b][m][n] = (f32x4){0.f, 0.f, 0.f, 0.f};
        cur = nxt; cA = nA; cB = nB; ++ui;
        if (wr == 1) PG8_BAR;
    }
    PG8_WAIT_V(0);
    PG8_BAR;
    if constexpr (Sched::SLICED) { if (tid == 0) S.nunits[S.c] = (unsigned)(ui + 1); }
#undef PG8_SA
#undef PG8_SB
#undef PG8_STAGE
#undef PG8_STAGE_A
#undef PG8_LDA
#undef PG8_LDB
#undef PG8_MMA
#undef PG8_WAIT_V
#undef PG8_WAIT_L
#undef PG8_BAR
#undef PG8_SCHED
}
}

#define XB_TMO      128
#define XB_XCNT(j)  (256  + 64 * (j))
#define XB_XSUB(j)  (1280 + 64 * (j))
#define XB_XGEN(j)  (2304 + 64 * (j))
#define XB_TOP      3328
#define XB_TOPGEN   3392
#define XCD_BAR_WORDS 3456
#define XB_SPIN_CAP (1u << 18)
__device__ __forceinline__ unsigned xb_ld(unsigned* p)              { return __hip_atomic_load(p, __ATOMIC_RELAXED, __HIP_MEMORY_SCOPE_AGENT); }
__device__ __forceinline__ unsigned xb_add(unsigned* p, unsigned v) { return __hip_atomic_fetch_add(p, v, __ATOMIC_RELAXED, __HIP_MEMORY_SCOPE_AGENT); }
__device__ __forceinline__ unsigned xb_xcc_id() { return (unsigned)__builtin_amdgcn_s_getreg((3 << 11) | 20) & 0xFu; }
#define XB_SPIN(cond, bar) do { unsigned _sp = 0; while (cond) { __builtin_amdgcn_s_sleep(1); \
    if ((++_sp & 255u) == 0u) { if (xb_ld(&(bar)[XB_TMO])) break; if (_sp > XB_SPIN_CAP) { atomicAdd(&(bar)[XB_TMO], 1u); break; } } } } while (0)
struct XcdBarrier { unsigned* bar; unsigned x; volatile LAS unsigned* st; };
__device__ __forceinline__ XcdBarrier xcd_barrier_post(unsigned* bar, volatile LAS unsigned* st) {
    XcdBarrier b; b.bar = bar; b.x = xb_xcc_id(); b.st = st;
    if (threadIdx.x == 0) (void)xb_add(&bar[XB_XCNT(b.x)], 1u);
    return b;
}
__device__ __forceinline__ void xcd_barrier_complete(unsigned* bar, unsigned x, unsigned& nloc, unsigned& nx) {
    const unsigned G = gridDim.x * gridDim.y * gridDim.z;
    unsigned sum, cnt, mine, sp = 0u;
    for (;;) {
        sum = 0u; cnt = 0u; mine = 0u;
#pragma unroll
        for (unsigned j = 0; j < 16; ++j) { const unsigned c = xb_ld(&bar[XB_XCNT(j)]); sum += c; cnt += (c > 0u) ? 1u : 0u; mine = (j == x) ? c : mine; }
        if (sum == G) break;
        __builtin_amdgcn_s_sleep(1);
        if ((++sp & 255u) == 0u) { if (xb_ld(&bar[XB_TMO])) break; if (sp > XB_SPIN_CAP) { atomicAdd(&bar[XB_TMO], 1u); break; } }
    }
    nloc = mine > 0u ? mine : 1u; nx = cnt > 0u ? cnt : 1u;
}
__device__ __forceinline__ void xcd_barrier(const XcdBarrier& b) {
    asm volatile("s_waitcnt vmcnt(0)" ::: "memory");
    __syncthreads();
    if (threadIdx.x == 0) {
        unsigned* bar = b.bar;
        __builtin_amdgcn_s_waitcnt(0);
        unsigned nloc = b.st[0], nx = b.st[1];
        if (nloc == 0u) { xcd_barrier_complete(bar, b.x, nloc, nx); b.st[0] = nloc; b.st[1] = nx; }
        const unsigned old = xb_add(&bar[XB_XSUB(b.x)], 1u);
        const unsigned gen = old / nloc;
        if (old + 1u == (gen + 1u) * nloc) {
            __builtin_amdgcn_fence(__ATOMIC_RELEASE, "agent");
            asm volatile("s_waitcnt vmcnt(0)" ::: "memory");
            const unsigned og = xb_add(&bar[XB_TOP], 1u);
            const unsigned tg = og / nx;
            if (og + 1u == (tg + 1u) * nx) xb_add(&bar[XB_TOPGEN], 1u);
            else XB_SPIN(xb_ld(&bar[XB_TOPGEN]) == tg, bar);
            __builtin_amdgcn_fence(__ATOMIC_ACQUIRE, "agent");
            xb_add(&bar[XB_XGEN(b.x)], 1u);
            asm volatile("s_waitcnt vmcnt(0)" ::: "memory");
        } else {
            XB_SPIN(xb_ld(&bar[XB_XGEN(b.x)]) == gen, bar);
            __builtin_amdgcn_fence(__ATOMIC_ACQUIRE, "agent");
            asm volatile("s_waitcnt vmcnt(0)" ::: "memory");
        }
    }
    __syncthreads();
}

namespace gla {
constexpr int QS = 272, SS = 144;
constexpr int L_QI = 0, L_KI = 17408, L_KD = 34816, L_V = 51200, L_ST = 83968, L_E = 93184, L_TOTP = 125952, L_DEC = 126976, L_O = 128000, L_GN = 160768, L_END = 161792;
__device__ __forceinline__ int v_st(int k, int c) { const int kk = (k & ~0xC) | ((k & 4) << 1) | ((k & 8) >> 1); return ((kk >> 3) * 4 + (c >> 5)) * 512 + ((kk & 7) * 32 + (c & 31)) * 2; }
__device__ __forceinline__ int v_rd_base(int lane) { return ((lane & 3) << 3) | (((lane >> 2) & 3) << 6) | (((lane >> 4) & 1) << 5) | (((lane >> 5) & 1) << 8); }
__host__ __device__ constexpr int v_rd_off(int d0, int ks, int half) { return d0 * 512 + ks * 4096 + half * 2048; }
__device__ __forceinline__ s16x4 tr_read(const LAS unsigned char* p) { return __builtin_bit_cast(s16x4, __builtin_amdgcn_ds_read_tr16_b64_v4i16((LAS s16x4*)p)); }
__device__ __forceinline__ bf16x8 cat8(s16x4 lo, s16x4 hi) { return __builtin_shufflevector(lo, hi, 0, 1, 2, 3, 4, 5, 6, 7); }
#define MFMA32(a, b, c) __builtin_amdgcn_mfma_f32_32x32x16_bf16((a), (b), (c), 0, 0, 0)
#define MFMA16(a, b, c) __builtin_amdgcn_mfma_f32_16x16x32_bf16((a), (b), (c), 0, 0, 0)

struct Tensors {
    const bf16_t *Q, *K, *V; const float* LR;
    const bf16_t *Kmeta, *Vmeta; const float* LRmeta;
    const float *wgf, *bgf, *wgb, *bgb;
    bf16_t *OF, *OB;
    bf16_t* A2; const float* gn;
};

__device__ __forceinline__ void unit(LAS unsigned char* lds, const Tensors& X, int b, int h, int dir, const XcdBarrier& xbar) {
    const int tid = threadIdx.x, lane = tid & 63, wid = __builtin_amdgcn_readfirstlane(tid >> 6), r32 = lane & 31, hi = lane >> 5;
    const int nsteps = dir ? 32 : 33, nmid = dir ? 16 : 17;
    if (tid < 64) *(LAS f32x4*)(lds + L_GN + tid * 16) = *(const f32x4*)(X.gn + tid * 4);
    if (wid < 4) {
        const int w = wid;
        f32x16 S[2][4];
#pragma unroll
        for (int ex = 0; ex < 2; ++ex)
#pragma unroll
            for (int i = 0; i < 4; ++i)
#pragma unroll
                for (int r = 0; r < 16; ++r) S[ex][i][r] = 0.f;
        const LAS unsigned char* const r_sc = lds + (lane & 15) * QS + (lane >> 4) * 16;
        LAS unsigned char* const w_st = lds + L_ST + (lane & 15) * SS + (lane >> 4) * 8;
        const LAS unsigned char* const r_qi = lds + L_QI + r32 * QS + hi * 8;
        const LAS unsigned char* const r_st = lds + L_ST + r32 * SS + hi * 16;
        const LAS unsigned char* const r_dec = lds + L_DEC + hi * 16;
        const LAS unsigned char* const vb0 = lds + L_V + (w >> 1) * 16384 + ((2 * w) & 3) * 512 + v_rd_base(lane);
        const LAS unsigned char* const kdbase = lds + L_KD + v_rd_base(lane);
        LAS unsigned char* const w_o = lds + L_O + (4 * hi) * 512 + (64 * w + r32) * 2;
        for (int n = -1; n < nsteps; ++n) {
            if (n == nmid) xcd_barrier(xbar);
            const bool second = n >= nmid;
            const int parM = (n & 1) * 512;
#pragma unroll
            for (int ti = 0; ti < 4; ++ti) {
                const int tj = w;
                f32x4 sc = {0.f, 0.f, 0.f, 0.f};
                if (dir == 0 ? (tj <= ti) : (tj >= ti)) {
                    const LAS unsigned char* pa = r_sc + L_KI + tj * (16 * QS); const LAS unsigned char* pb = r_sc + L_QI + ti * (16 * QS);
#pragma unroll
                    for (int ks = 0; ks < 4; ++ks) sc = MFMA16(*(const LAS bf16x8*)(pa + ks * 64), *(const LAS bf16x8*)(pb + ks * 64), sc);
                }
                const int i = 16 * ti + (lane & 15), j0 = 16 * tj + 4 * (lane >> 4);
#pragma unroll
                for (int r = 0; r < 4; ++r) { const int j = j0 + r; const bool keep = dir == 0 ? (j <= i) : (j > i); if (!keep) sc[r] = 0.f; }
                *(LAS u32x2*)(w_st + ti * (16 * SS) + tj * 32) = (u32x2){pk2(sc[0], sc[1]), pk2(sc[2], sc[3])};
            }
            f32x16 o[2][2];
#pragma unroll
            for (int ex = 0; ex < 2; ++ex)
#pragma unroll
                for (int r = 0; r < 16; ++r) { o[ex][0][r] = 0.f; o[ex][1][r] = 0.f; }
            {
                bf16x8 af[2][2];
#define GLA_LDQ(buf, step_) do { _Pragma("unroll") for (int it_ = 0; it_ < 2; ++it_) { const LAS unsigned char* p_ = r_qi + it_ * (32 * QS) + ((step_) >> 1) * 64 + ((step_) & 1) * 32; \
                    af[buf][it_] = cat8(*(const LAS s16x4*)(p_), *(const LAS s16x4*)(p_ + 16)); } } while (0)
                GLA_LDQ(0, 0);
#pragma unroll
                for (int st = 0; st < 8; ++st) {
                    const int dt = st >> 1, s = st & 1;
                    if (st < 7) GLA_LDQ((st + 1) & 1, st + 1);
#pragma unroll
                    for (int ex = 0; ex < 2; ++ex) {
                        u32x4 bw; bw.x = pk2(S[ex][dt][8 * s + 0], S[ex][dt][8 * s + 1]); bw.y = pk2(S[ex][dt][8 * s + 2], S[ex][dt][8 * s + 3]);
                        bw.z = pk2(S[ex][dt][8 * s + 4], S[ex][dt][8 * s + 5]); bw.w = pk2(S[ex][dt][8 * s + 6], S[ex][dt][8 * s + 7]);
                        const bf16x8 bfr = __builtin_bit_cast(bf16x8, bw);
#pragma unroll
                        for (int it = 0; it < 2; ++it) o[ex][it] = MFMA32(af[st & 1][it], bfr, o[ex][it]);
                    }
                }
#undef GLA_LDQ
            }
            LBAR();
#pragma unroll
            for (int ex = 0; ex < 2; ++ex) {
#pragma unroll
                for (int ks = 0; ks < 4; ++ks) {
                    const bf16x8 bv = cat8(tr_read(vb0 + ex * 512 + v_rd_off(0, ks, 0)), tr_read(vb0 + ex * 512 + v_rd_off(0, ks, 1)));
#pragma unroll
                    for (int it = 0; it < 2; ++it) o[ex][it] = MFMA32(*(const LAS bf16x8*)(r_st + it * (32 * SS) + ks * 32), bv, o[ex][it]);
                }
#pragma unroll
                for (int it = 0; it < 2; ++it)
#pragma unroll
                    for (int r = 0; r < 16; ++r) *(LAS bf16_t*)(w_o + ex * 64 + (32 * it + (r & 3) + 8 * (r >> 2)) * 512) = (bf16_t)(pk2(o[ex][it][r], 0.f) & 0xffffu);
            }
            LBAR();
            {
                bf16x8 Bv[2][4];
#pragma unroll
                for (int ex = 0; ex < 2; ++ex)
#pragma unroll
                    for (int ks = 0; ks < 4; ++ks) Bv[ex][ks] = cat8(tr_read(vb0 + ex * 512 + v_rd_off(0, ks, 0)), tr_read(vb0 + ex * 512 + v_rd_off(0, ks, 1)));
                bf16x8 kf[2][4];
#define GLA_LDK(buf, dt_) do { _Pragma("unroll") for (int ks_ = 0; ks_ < 4; ++ks_) kf[buf][ks_] = cat8(tr_read(kdbase + v_rd_off((dt_), ks_, 0)), tr_read(kdbase + v_rd_off((dt_), ks_, 1))); } while (0)
                GLA_LDK(0, 0);
#pragma unroll
                for (int dt = 0; dt < 4; ++dt) {
                    if (dt < 3) GLA_LDK((dt + 1) & 1, dt + 1);
#pragma unroll
                    for (int g4 = 0; g4 < 4; ++g4) {
                        const f32x4 dc = *(const LAS f32x4*)(r_dec + parM + dt * 128 + g4 * 32);
#pragma unroll
                        for (int x = 0; x < 4; ++x) { S[0][dt][4 * g4 + x] *= dc[x]; S[1][dt][4 * g4 + x] *= dc[x]; }
                    }
#pragma unroll
                    for (int ex = 0; ex < 2; ++ex)
#pragma unroll
                        for (int ks = 0; ks < 4; ++ks) S[ex][dt] = MFMA32(kf[dt & 1][ks], Bv[ex][ks], S[ex][dt]);
                }
#undef GLA_LDK
            }
            if (n < 0) {
#pragma unroll
                for (int ex = 0; ex < 2; ++ex)
#pragma unroll
                    for (int i = 0; i < 4; ++i)
#pragma unroll
                        for (int r = 0; r < 16; ++r) S[ex][i][r] = 0.f;
            }
            LBAR();
        }
    } else {
        const int w4 = wid - 4, ptid = tid - 256;
        const int gd = w4 * 32 + r32;
        const float* wg = dir ? X.wgb : X.wgf; const float* bg = dir ? X.bgb : X.bgf;
        bf16x8 Bhi, Blo;
        {
            float wv[8]; unsigned whi[4], wlo[4];
#pragma unroll
            for (int jj = 0; jj < 8; ++jj) wv[jj] = -1.4426950408889634f * wg[(8 * hi + jj) * 512 + h * DK + gd];
#pragma unroll
            for (int p = 0; p < 4; ++p) { whi[p] = pk2(wv[2 * p], wv[2 * p + 1]); wlo[p] = pk2(wv[2 * p] - bflo(whi[p]), wv[2 * p + 1] - bfhi(whi[p])); }
            Bhi = __builtin_bit_cast(bf16x8, (u32x4){whi[0], whi[1], whi[2], whi[3]}); Blo = __builtin_bit_cast(bf16x8, (u32x4){wlo[0], wlo[1], wlo[2], wlo[3]});
        }
        const float bias = -1.4426950408889634f * bg[h * DK + gd];
        u32x4 qreg[4], kreg[4], vreg[8]; f32x4 lrreg[2][2];
        const int qj0 = ptid >> 4, qo = ptid & 15;
        const int prow = ptid >> 4, pc = (ptid & 15) * 16;
        const unsigned lo_qk = (unsigned)(qj0 * 512 + qo * 8), lo_v = (unsigned)(qj0 * D + qo * 8), lo_lr = (unsigned)(r32 * 32 + 8 * hi);
#define GLA_CHUNK_PTRS(step_) const int s_ = (step_); const bf16_t *qp_, *kp_, *vp_; const float* lp_; \
        if (dir == 0 && s_ == 0) { qp_ = X.Kmeta + h * DK; kp_ = qp_; vp_ = X.Vmeta + h * DV; lp_ = X.LRmeta; } \
        else { const int c_ = dir ? (31 - s_) : (s_ - 1); const size_t rb_ = (size_t)b * T + (size_t)c_ * CH; \
               qp_ = X.Q + rb_ * 512 + h * DK; kp_ = X.K + rb_ * 512 + h * DK; vp_ = X.V + rb_ * D + h * DV; lp_ = X.LR + rb_ * 32 + dir * 16; } \
        (void)qp_; (void)kp_; (void)vp_; (void)lp_;
#define GLA_LOAD_QK(step_) do { GLA_CHUNK_PTRS(step_) _Pragma("unroll") for (int it = 0; it < 4; ++it) { qreg[it] = *(const u32x4*)((qp_ + it * 16 * 512) + lo_qk); kreg[it] = *(const u32x4*)((kp_ + it * 16 * 512) + lo_qk); } } while (0)
#define GLA_LOAD_V(step_) do { GLA_CHUNK_PTRS(step_) _Pragma("unroll") for (int itr = 0; itr < 4; ++itr) _Pragma("unroll") for (int itp = 0; itp < 2; ++itp) vreg[itr * 2 + itp] = *(const u32x4*)((vp_ + (16 * itr) * D + itp * 128) + lo_v); } while (0)
#define GLA_STORE_V() do { _Pragma("unroll") for (int itr = 0; itr < 4; ++itr) _Pragma("unroll") for (int itp = 0; itp < 2; ++itp) *(LAS u32x4*)(w_v + itr * 4096 + itp * 16384) = vreg[itr * 2 + itp]; } while (0)
#define GLA_LOAD_LR(step_) do { GLA_CHUNK_PTRS(step_) _Pragma("unroll") for (int tj = 0; tj < 2; ++tj) { lrreg[tj][0] = *(const f32x4*)((lp_ + tj * 32 * 32) + lo_lr); lrreg[tj][1] = *(const f32x4*)((lp_ + tj * 32 * 32 + 4) + lo_lr); } } while (0)
#define GLA_CLAMP(s_) ((s_) < nsteps ? (s_) : nsteps - 1)
        GLA_LOAD_LR(0);
        LAS unsigned char* const w_e = lds + L_E + ((4 * hi) * 128 + gd) * 4;
        const LAS unsigned char* const r_e = lds + L_E + (qj0 * 128 + qo * 8) * 4;
        const LAS unsigned char* const r_dc = lds + L_DEC + qo * 32;
        LAS unsigned char* const w_qi = lds + L_QI + qj0 * QS + qo * 16;
        LAS unsigned char* const w_kd = lds + L_KD + v_st(qj0, qo * 8);
        LAS unsigned char* const w_v = lds + L_V + v_st(qj0, qo * 8);
        const LAS unsigned char* const r_o = lds + L_O + prow * 512 + pc * 2;
        const LAS unsigned char* const r_gn = lds + L_GN + pc * 4;
        unsigned kd[4][4];
#pragma unroll
        for (int it = 0; it < 4; ++it)
#pragma unroll
            for (int p = 0; p < 4; ++p) kd[it][p] = 0u;
        for (int n = -1; n < nsteps; ++n) {
            if (n == nmid) xcd_barrier(xbar);
            const bool second = n >= nmid;
            const int parP = ((n + 1) & 1) * 512;
            if (n >= 0) {
#pragma unroll
                for (int it = 0; it < 4; ++it) *(LAS u32x4*)(w_kd + it * 4096) = (u32x4){kd[it][0], kd[it][1], kd[it][2], kd[it][3]};
            }
            GLA_LOAD_QK(GLA_CLAMP(n + 1));
            {
                float base = 0.f;
#define GLA_GATE_Z(tj, z) do { \
                    const f32x4 l0 = lrreg[tj][0], l1 = lrreg[tj][1]; \
                    unsigned ah[4], al[4]; \
                    ah[0] = pk2(l0[0], l0[1]); ah[1] = pk2(l0[2], l0[3]); ah[2] = pk2(l1[0], l1[1]); ah[3] = pk2(l1[2], l1[3]); \
                    al[0] = pk2(l0[0] - bflo(ah[0]), l0[1] - bfhi(ah[0])); al[1] = pk2(l0[2] - bflo(ah[1]), l0[3] - bfhi(ah[1])); \
                    al[2] = pk2(l1[0] - bflo(ah[2]), l1[1] - bfhi(ah[2])); al[3] = pk2(l1[2] - bflo(ah[3]), l1[3] - bfhi(ah[3])); \
                    const bf16x8 Ahi = __builtin_bit_cast(bf16x8, (u32x4){ah[0], ah[1], ah[2], ah[3]}), Alo = __builtin_bit_cast(bf16x8, (u32x4){al[0], al[1], al[2], al[3]}); \
                    _Pragma("unroll") for (int r = 0; r < 16; ++r) z[r] = 0.f; \
                    z = MFMA32(Ahi, Bhi, z); z = MFMA32(Ahi, Blo, z); z = MFMA32(Alo, Bhi, z); \
                } while (0)
#define GLA_GATE_TILE(tj, z) do { \
                    float e[16], G[4], PG[4]; \
                    _Pragma("unroll") for (int g4 = 0; g4 < 4; ++g4) { \
                        float gv[4]; \
                        _Pragma("unroll") for (int x = 0; x < 4; ++x) gv[x] = __builtin_amdgcn_logf(1.f + __builtin_amdgcn_exp2f(z[4 * g4 + x] + bias));     \
                        if (dir == 0) { e[4 * g4] = gv[0]; e[4 * g4 + 1] = gv[0] + gv[1]; e[4 * g4 + 2] = e[4 * g4 + 1] + gv[2]; e[4 * g4 + 3] = e[4 * g4 + 2] + gv[3]; G[g4] = e[4 * g4 + 3]; } \
                        else          { e[4 * g4 + 3] = gv[3]; e[4 * g4 + 2] = gv[3] + gv[2]; e[4 * g4 + 1] = e[4 * g4 + 2] + gv[1]; e[4 * g4] = e[4 * g4 + 1] + gv[0]; G[g4] = e[4 * g4]; } \
                        PG[g4] = get_x32(G[g4], hi); \
                    } \
                    float pre[4], run = base; \
                    if (dir == 0) { _Pragma("unroll") for (int g4 = 0; g4 < 4; ++g4) { pre[g4] = run + (hi ? PG[g4] : 0.f); run += G[g4] + PG[g4]; } } \
                    else          { _Pragma("unroll") for (int g4 = 3; g4 >= 0; --g4) { pre[g4] = run + (hi ? 0.f : PG[g4]); run += G[g4] + PG[g4]; } } \
                    base = run; \
                    _Pragma("unroll") for (int r = 0; r < 16; ++r) *(LAS float*)(w_e + (32 * (tj) + 8 * (r >> 2) + (r & 3)) * 512) = (e[r] + pre[r >> 2]) * -0.0625f; \
                } while (0)
                f32x16 z0, z1;
                GLA_GATE_Z(0, z0); GLA_GATE_Z(1, z1);
                if (dir == 0) { GLA_GATE_TILE(0, z0); GLA_GATE_TILE(1, z1); } else { GLA_GATE_TILE(1, z1); GLA_GATE_TILE(0, z0); }
#undef GLA_GATE_TILE
#undef GLA_GATE_Z
                if (hi == 0) *(LAS float*)(lds + L_DEC + parP + gd * 4) = __builtin_amdgcn_exp2f(-0.0625f * base);
            }
            if (n >= 0) GLA_STORE_V();

            LBAR();
            GLA_LOAD_LR(GLA_CLAMP(n + 2));
#pragma unroll
            for (int it = 0; it < 4; ++it) {
                const f32x4 e0 = *(const LAS f32x4*)(r_e + it * 8192), e1 = *(const LAS f32x4*)(r_e + it * 8192 + 16);
                const f32x4 t0 = *(const LAS f32x4*)(r_dc + parP), t1 = *(const LAS f32x4*)(r_dc + parP + 16);
                const float ev[8] = {e0[0], e0[1], e0[2], e0[3], e1[0], e1[1], e1[2], e1[3]}, tv[8] = {t0[0], t0[1], t0[2], t0[3], t1[0], t1[1], t1[2], t1[3]};
                const unsigned qw[4] = {qreg[it].x, qreg[it].y, qreg[it].z, qreg[it].w}, kw[4] = {kreg[it].x, kreg[it].y, kreg[it].z, kreg[it].w};
                unsigned qi[4], ki[4];
#pragma unroll
                for (int p = 0; p < 4; ++p) {
                    const float q0 = bflo(qw[p]), q1 = bfhi(qw[p]);
                    const float k0 = bflo(kw[p]) * __builtin_amdgcn_exp2f(-ev[2 * p]), k1 = bfhi(kw[p]) * __builtin_amdgcn_exp2f(-ev[2 * p + 1]);
                    qi[p] = pk2(q0 * __builtin_amdgcn_exp2f(ev[2 * p]), q1 * __builtin_amdgcn_exp2f(ev[2 * p + 1]));
                    ki[p] = pk2(k0, k1);
                    kd[it][p] = pk2(k0 * tv[2 * p], k1 * tv[2 * p + 1]);
                }
                *(LAS u32x4*)(w_qi + it * 16 * QS) = (u32x4){qi[0], qi[1], qi[2], qi[3]};
                *(LAS u32x4*)(w_qi + (L_KI - L_QI) + it * 16 * QS) = (u32x4){ki[0], ki[1], ki[2], ki[3]};
                __builtin_amdgcn_sched_barrier(0);
            }
            if (!second) {
                LBAR();
                if (n >= 0 && !(dir == 0 && n == 0)) {
                    const int c = dir ? (31 - n) : (n - 1);
                    bf16_t* ob_ = (dir ? X.OB : X.OF) + ((size_t)b * T + (size_t)c * CH) * D + h * DV;
                    const unsigned lo_o = (unsigned)(prow * D + pc);
#pragma unroll
                    for (int sub = 0; sub < 4; ++sub) {
                        const u32x4 a0 = *(const LAS u32x4*)(r_o + sub * (16 * 512)), a1 = *(const LAS u32x4*)(r_o + sub * (16 * 512) + 16);
                        bf16_t* po_ = ob_ + (lo_o + (unsigned)(16 * sub * D));
                        *(u32x4*)(po_) = a0; *(u32x4*)(po_ + 8) = a1;
                    }
                }
            } else {
                u32x4 oo[2][2], rr4[2][2];
                const int c = dir ? (31 - n) : (n - 1);
                const bf16_t* ob_ = (dir ? X.OF : X.OB) + ((size_t)b * T + (size_t)c * CH) * D + h * DV;
                bf16_t* rb2_ = X.A2 + a2_off(b * T + c * CH, D + h * DV);
                const unsigned lo_o = (unsigned)(prow * D + pc), lo_r = (unsigned)(prow * 64 + (pc & 63) + (pc >> 6) * (256 * 64));
#define GLA_ROWLOAD(slot_, sub_) do { const bf16_t* po_ = ob_ + (lo_o + (unsigned)(16 * (sub_) * D)); const bf16_t* pr_ = rb2_ + (lo_r + (unsigned)(16 * (sub_) * 64)); \
                    oo[slot_][0] = *(const u32x4*)(po_); oo[slot_][1] = *(const u32x4*)(po_ + 8); rr4[slot_][0] = *(const u32x4*)(pr_); rr4[slot_][1] = *(const u32x4*)(pr_ + 8); } while (0)
                GLA_ROWLOAD(0, 0); GLA_ROWLOAD(1, 1);
                LBAR();
#pragma unroll
                for (int sub = 0; sub < 4; ++sub) {
                    bf16_t* py = rb2_ + (lo_r + (unsigned)(16 * sub * 64));
                    float v[16]; float ss = 0.f;
#pragma unroll
                    for (int q = 0; q < 2; ++q) {
                        const u32x4 mine = *(const LAS u32x4*)(r_o + sub * (16 * 512) + 16 * q), oth = oo[sub & 1][q];
                        v[8 * q + 0] = bflo(mine.x) + bflo(oth.x); v[8 * q + 1] = bfhi(mine.x) + bfhi(oth.x); v[8 * q + 2] = bflo(mine.y) + bflo(oth.y); v[8 * q + 3] = bfhi(mine.y) + bfhi(oth.y);
                        v[8 * q + 4] = bflo(mine.z) + bflo(oth.z); v[8 * q + 5] = bfhi(mine.z) + bfhi(oth.z); v[8 * q + 6] = bflo(mine.w) + bflo(oth.w); v[8 * q + 7] = bfhi(mine.w) + bfhi(oth.w);
                    }
                    const u32x4 rw0 = rr4[sub & 1][0], rw1 = rr4[sub & 1][1];
                    if (sub < 2) GLA_ROWLOAD(sub & 1, sub + 2);
#pragma unroll
                    for (int e2 = 0; e2 < 16; ++e2) ss += v[e2] * v[e2];
                    ss = row16_sum(ss);
                    const float rstd = __builtin_amdgcn_rsqf(ss * (1.f / DV) + EPS);
#pragma unroll
                    for (int q = 0; q < 2; ++q) {
                        const f32x4 g0 = *(const LAS f32x4*)(r_gn + 32 * q), g1 = *(const LAS f32x4*)(r_gn + 32 * q + 16);
                        const u32x4 rw = q ? rw1 : rw0;
                        const float rv[8] = {bflo(rw.x), bfhi(rw.x), bflo(rw.y), bfhi(rw.y), bflo(rw.z), bfhi(rw.z), bflo(rw.w), bfhi(rw.w)};
                        const float gg[8] = {g0[0], g0[1], g0[2], g0[3], g1[0], g1[1], g1[2], g1[3]};
                        float zz[8];
#pragma unroll
                        for (int e2 = 0; e2 < 8; ++e2) zz[e2] = v[8 * q + e2] * rstd * gg[e2] * rv[e2] * sigm(rv[e2]);
                        *(u32x4*)(py + 8 * q) = (u32x4){pk2(zz[0], zz[1]), pk2(zz[2], zz[3]), pk2(zz[4], zz[5]), pk2(zz[6], zz[7])};
                    }
                }
#undef GLA_ROWLOAD
            }
            GLA_LOAD_V(GLA_CLAMP(n + 1));
            LBAR();
        }
#undef GLA_CHUNK_PTRS
#undef GLA_LOAD_QK
#undef GLA_LOAD_V
#undef GLA_STORE_V
#undef GLA_LOAD_LR
#undef GLA_CLAMP
    }
}
}

constexpr int NWAVES = 8, LDS_BYTES = 162304, MISC_OFF = 162048, CONV_STG = 131072, CONV_STG_WAVE = 2304;
constexpr size_t WS_CTL = 0, CTL_BYTES = 32768;
struct Args { const float* in[14]; float* out; unsigned char* ws; int ph_lo, ph_hi; };
struct Frame {
    LAS unsigned char* lds; int tid, lane, wave, G, vcu;
    const float *x, *meta, *g_pre, *w_in, *conv_w, *wgf, *bgf, *wgb, *bgb, *gn, *w_oc, *w_og, *w_mo, *g_post;
    float* out; unsigned char* ws;
};
__device__ __forceinline__ int deal_row(int k, int gw, int NGW) { return k * NGW + ((gw + 488 * k) & (NGW - 1)); }
__device__ __forceinline__ float wave_sum(float v) {
    return sum_x32(sum_x16(row16_sum(v)));
}
__device__ __forceinline__ int win_src_col(int r) {
    const int pn = r >> 8, s = r & 255, bj = s >> 7, wc = (s >> 5) & 3, n = (s >> 4) & 1, fq = (s >> 2) & 3, e = s & 3;
    if (pn < 16) return (2 * bj + n) * 1024 + pn * 64 + wc * 16 + fq * 4 + e;
    const int oc = 128 * bj + 32 * wc + 8 * fq + 4 * n + e;
    if (pn < 18) return O_Q + (pn - 16) * 256 + oc;
    if (pn < 20) return O_K + (pn - 18) * 256 + oc;
    if (pn < 24) return O_V + (pn - 20) * 256 + oc;
    if (pn < 28) return O_R + (pn - 24) * 256 + oc;
    if (pn < 36) return (bj ? O_MB : O_MA) + (pn - 28) * 128 + 32 * wc + 8 * fq + 4 * n + e;
    return s < 32 ? O_LRF + s : -1;
}
__device__ __forceinline__ int perm_col(int r) {
    const int pn = r >> 8, s = r & 255, bj = s >> 7, wc = (s >> 5) & 3, n = (s >> 4) & 1, fq = (s >> 2) & 3, e = s & 3;
    return pn * 256 + 128 * bj + 32 * wc + 8 * fq + 4 * n + e;
}
template <class SrcFn> __device__ __forceinline__ void transpose_item(SrcFn src, bf16_t* Wt, int Kd, int r0, int k0, LAS float* scr, int lane) {
    float tv[32];
#pragma unroll
    for (int i = 0; i < 32; ++i) tv[i] = src(k0 + 2 * i + (lane >> 5), r0 + (lane & 31));
#pragma unroll
    for (int i = 0; i < 32; ++i) scr[(2 * i + (lane >> 5)) * 33 + (lane & 31)] = tv[i];
    LDS_WAIT(); asm volatile("" ::: "memory");
    const int c = lane & 7;
#pragma unroll
    for (int j = 0; j < 4; ++j) { const int n = (lane >> 3) + 8 * j; const LAS float* s = scr + (8 * c) * 33 + n;
        u32x4 o; o.x = pk2(s[0 * 33], s[1 * 33]); o.y = pk2(s[2 * 33], s[3 * 33]); o.z = pk2(s[4 * 33], s[5 * 33]); o.w = pk2(s[6 * 33], s[7 * 33]);
        *(u32x4*)(Wt + (size_t)(r0 + n) * Kd + k0 + 8 * c) = o; }
    LDS_WAIT(); asm volatile("" ::: "memory");
}
constexpr int META_JOBS = 57, META_KQ = 4, META_ITEMS = META_JOBS * META_KQ, META_COLS = META_JOBS * 64;
constexpr size_t WS_MPART = 48 * MiB;
__device__ __forceinline__ void p0_meta(Frame& F, int item) {
    const int job = item >> 2, kq = item & 3;
    LAS float* umT = (LAS float*)F.lds;
    LAS float* red = (LAS float*)(F.lds + 65536);
    for (int rr = 0; rr < 2; ++rr) {
        const int j = 2 * F.wave + rr; const float* mr = F.meta + (size_t)j * D;
        f32x4 v[4]; float s = 0.f;
#pragma unroll
        for (int q = 0; q < 4; ++q) { v[q] = *(const f32x4*)(mr + 4 * F.lane + 256 * q); s += (v[q][0] * v[q][0] + v[q][1] * v[q][1]) + (v[q][2] * v[q][2] + v[q][3] * v[q][3]); }
        const float rstd = 1.0f / sqrtf(wave_sum(s) * (1.f / D) + EPS);
#pragma unroll
        for (int q = 0; q < 4; ++q)
#pragma unroll
            for (int e = 0; e < 4; ++e) { const int col = 4 * F.lane + 256 * q + e; umT[col * 16 + j] = v[q][e] * rstd * F.g_pre[col]; }
    }
    __syncthreads();
    const int ci = job * 64 + F.lane;
    const bool valid = ci < 3600;
    const int src = ci < 2048 ? (O_CC + ci) : (ci < 3584 ? (O_K + (ci - 2048)) : (valid ? O_LRF + (ci - 3584) : 0));
    float acc[16];
#pragma unroll
    for (int j = 0; j < 16; ++j) acc[j] = 0.f;
    const int kbase = kq * 256 + F.wave * 32;
    const float* wp = F.w_in + src + (size_t)kbase * NIN;
    const LAS float* up = umT + kbase * 16;
#pragma unroll 1
    for (int k0 = 0; k0 < 32; k0 += 16) {
        float w[16];
#pragma unroll
        for (int i = 0; i < 16; ++i) w[i] = wp[(size_t)(k0 + i) * NIN];
#pragma unroll
        for (int i = 0; i < 16; ++i) {
            const LAS f32x4* u4 = (const LAS f32x4*)(up + (k0 + i) * 16);
#pragma unroll
            for (int q = 0; q < 4; ++q) { const f32x4 u = u4[q]; acc[4 * q] += w[i] * u[0]; acc[4 * q + 1] += w[i] * u[1]; acc[4 * q + 2] += w[i] * u[2]; acc[4 * q + 3] += w[i] * u[3]; }
            if ((i & 1) == 1) __builtin_amdgcn_sched_barrier(0);
        }
    }
#pragma unroll
    for (int j = 0; j < 16; ++j) red[(F.wave * 16 + j) * 64 + F.lane] = acc[j];
    __syncthreads();
    float* part = (float*)(F.ws + WS_MPART) + (size_t)kq * 16 * META_COLS;
    for (int o = F.tid; o < 1024; o += NWAVES * 64) {
        const int j = o >> 6, c = o & 63;
        float s = 0.f;
#pragma unroll
        for (int w = 0; w < 8; ++w) s += red[(w * 16 + j) * 64 + c];
        part[j * META_COLS + job * 64 + c] = s;
    }
    __syncthreads();
}
__device__ __forceinline__ void meta_reduce(Frame& F, int job) {
    const float* part = (const float*)(F.ws + WS_MPART);
    unsigned char* mb = F.ws + WS_META;
    bf16_t* kmeta = (bf16_t*)(mb + META_K); bf16_t* vmeta = (bf16_t*)(mb + META_V); float* lrm = (float*)(mb + META_LR);
    for (int o = F.tid; o < 1024; o += NWAVES * 64) {
        const int j = o >> 6, c = o & 63, cj = job * 64 + c;
        float s = 0.f;
#pragma unroll
        for (int q = 0; q < META_KQ; ++q) s += part[((size_t)q * 16 + j) * META_COLS + cj];
        if (cj < 1024) { if (j == 15) ((float*)(mb + META_CC))[cj] = s; }
        else if (cj < 2048) { if (j == 15) ((float*)(mb + META_CX))[cj - 1024] = s; }
        else if (cj < 2560) kmeta[(48 + j) * 512 + (cj - 2048)] = (bf16_t)(pk2(s, 0.f) & 0xffffu);
        else if (cj < 3584) vmeta[(48 + j) * 1024 + (cj - 2560)] = (bf16_t)(pk2(s, 0.f) & 0xffffu);
        else if (cj < 3600) { lrm[(48 + j) * 32 + (cj - 3584)] = s; lrm[(48 + j) * 32 + 16 + (cj - 3584)] = 0.f; }
    }
    for (int o = F.tid; o < 48 * 64; o += NWAVES * 64) {
        const int j = o >> 6, cj = job * 64 + (o & 63);
        if (cj >= 2048 && cj < 2560) kmeta[j * 512 + (cj - 2048)] = 0;
        else if (cj >= 2560 && cj < 3584) vmeta[j * 1024 + (cj - 2560)] = 0;
        else if (cj >= 3584 && cj < 3600) { lrm[j * 32 + (cj - 3584)] = 0.f; lrm[j * 32 + 16 + (cj - 3584)] = 0.f; }
    }
}
__device__ __forceinline__ void p0_prologue(Frame& F) {
    const bool meta_first = (((int)blockIdx.x >> 3) & 1) == 0;
    if (meta_first && blockIdx.x < META_ITEMS) p0_meta(F, (int)blockIdx.x);
    LAS float* scr = (LAS float*)(F.lds + F.wave * 16384);
    const int gw = F.vcu * NWAVES + F.wave, NGW = F.G * NWAVES;
    bf16_t* Wt_in = (bf16_t*)(F.ws + WS_WIN); bf16_t* Wt_mg = (bf16_t*)(F.ws + WS_WMG); bf16_t* Wt_out = (bf16_t*)(F.ws + WS_WOUT);
    constexpr int I_IN = (NSLOT / 32) * (D / 64), I_MG = (D / 32) * (2 * D / 64), I_OUT = (D / 32) * (D / 64);
    const float* w_in = F.w_in; const float* w_oc = F.w_oc; const float* w_og = F.w_og; const float* w_mo = F.w_mo;
    for (int it = gw; it < I_IN + I_MG + I_OUT; it += NGW) {
        int r = it;
        if (r < I_IN) { const int rb = r / (D / 64), kb = r % (D / 64);
            transpose_item([=](int k, int row) { const int c = win_src_col(row); return c < 0 ? 0.f : w_in[(size_t)k * NIN + c]; }, Wt_in, D, rb * 32, kb * 64, scr, F.lane); continue; }
        r -= I_IN;
        if (r < I_MG) { const int rb = r / (2 * D / 64), kb = r % (2 * D / 64);
            transpose_item([=](int k, int row) { const int c = perm_col(row); return k < D ? w_oc[(size_t)k * D + c] : w_og[(size_t)(k - D) * D + c]; }, Wt_mg, 2 * D, rb * 32, kb * 64, scr, F.lane); continue; }
        r -= I_MG;
        { const int rb = r / (D / 64), kb = r % (D / 64);
            transpose_item([=](int k, int row) { return w_mo[(size_t)k * D + perm_col(row)]; }, Wt_out, D, rb * 32, kb * 64, scr, F.lane); }
    }
    bf16_t* U = (bf16_t*)(F.ws + WS_U); float* rmsx = (float*)(F.ws + WS_RMS);
    f32x4 gp[4];
#pragma unroll
    for (int q = 0; q < 4; ++q) gp[q] = *(const f32x4*)(F.g_pre + 4 * F.lane + 256 * q);
    for (int k = 0; k < M / 4 / NGW; k += 2) {
        const int r1 = deal_row(k, gw, NGW), r2 = deal_row(k + 1, gw, NGW);
        const int m = (r1 >> 11) * 8192 + (r1 & 2047), m2 = (r2 >> 11) * 8192 + (r2 & 2047);
        const float* xr = F.x + (size_t)m * D + 4 * F.lane; const float* xr2 = F.x + (size_t)m2 * D + 4 * F.lane;
        f32x4 v[4], w[4]; float s = 0.f, s2 = 0.f;
#pragma unroll
        for (int q = 0; q < 4; ++q) { v[q] = __builtin_nontemporal_load((const f32x4*)(xr + 256 * q)); w[q] = __builtin_nontemporal_load((const f32x4*)(xr2 + 256 * q)); }
#pragma unroll
        for (int q = 0; q < 4; ++q) { s += (v[q][0] * v[q][0] + v[q][1] * v[q][1]) + (v[q][2] * v[q][2] + v[q][3] * v[q][3]); s2 += (w[q][0] * w[q][0] + w[q][1] * w[q][1]) + (w[q][2] * w[q][2] + w[q][3] * w[q][3]); }
        const float ms = wave_sum(s) * (1.f / D) + EPS, ms2 = wave_sum(s2) * (1.f / D) + EPS;
        const float rstd = __builtin_amdgcn_rsqf(ms), rstd2 = __builtin_amdgcn_rsqf(ms2);
        if (F.lane == 0) { rmsx[m] = ms * rstd; rmsx[m2] = ms2 * rstd2; }
        bf16_t* ur = U + (size_t)m * D + 4 * F.lane; bf16_t* ur2 = U + (size_t)m2 * D + 4 * F.lane;
#pragma unroll
        for (int q = 0; q < 4; ++q) { const f32x4 y = v[q] * rstd * gp[q], y2 = w[q] * rstd2 * gp[q];
            *(u32x2*)(ur + 256 * q) = (u32x2){pk2(y[0], y[1]), pk2(y[2], y[3])}; *(u32x2*)(ur2 + 256 * q) = (u32x2){pk2(y2[0], y2[1]), pk2(y2[2], y2[3])}; }
    }
    if (!meta_first && blockIdx.x < META_ITEMS) { __syncthreads(); p0_meta(F, (int)blockIdx.x); }
}
__device__ __forceinline__ void conv_fixup(Frame& F) {
    const int gw = F.vcu * NWAVES + F.wave, NGW = F.G * NWAVES;
    const bf16_t* SP = (const bf16_t*)(F.ws + WS_SIDEP); const bf16_t* SG = (const bf16_t*)(F.ws + WS_SIDEG); bf16_t* A2 = (bf16_t*)(F.ws + WS_A2);
    const float* cc15 = (const float*)(F.ws + WS_META + META_CC); const float* cx15 = (const float*)(F.ws + WS_META + META_CX);
    for (int i = gw; i < M / 32; i += NGW) {
        const int run = i >> 1; const bool first = (i & 1) == 0;
        const int t = run * 64 + (first ? 0 : 63), tl = t & (T - 1);
#pragma unroll
        for (int half = 0; half < 2; ++half) {
            const int c0 = half * 512 + 8 * F.lane;
            const u32x4 yq = *(const u32x4*)(A2 + a2_off(t, c0));
            const u32x4 gq = *(const u32x4*)(SG + ((size_t)run * 2 + (first ? 0 : 1)) * D + c0);
            float pn_[8];
            if (first ? (tl != 0) : (tl != T - 1)) {
                const u32x4 w = *(const u32x4*)(SP + ((size_t)(first ? run - 1 : run + 1) * 2 + (first ? 1 : 0)) * D + c0);
                pn_[0] = bflo(w.x); pn_[1] = bfhi(w.x); pn_[2] = bflo(w.y); pn_[3] = bfhi(w.y); pn_[4] = bflo(w.z); pn_[5] = bfhi(w.z); pn_[6] = bflo(w.w); pn_[7] = bfhi(w.w);
            } else {
#pragma unroll
                for (int e = 0; e < 8; ++e) pn_[e] = first ? cc15[c0 + e] * cx15[c0 + e] : 0.f;
            }
            const float yv[8] = {bflo(yq.x), bfhi(yq.x), bflo(yq.y), bfhi(yq.y), bflo(yq.z), bfhi(yq.z), bflo(yq.w), bfhi(yq.w)};
            const float gg[8] = {bflo(gq.x), bfhi(gq.x), bflo(gq.y), bfhi(gq.y), bflo(gq.z), bfhi(gq.z), bflo(gq.w), bfhi(gq.w)};
            float y[8];
#pragma unroll
            for (int e = 0; e < 8; ++e) y[e] = yv[e] + gg[e] * F.conv_w[(first ? 0 : 2 * D) + c0 + e] * pn_[e];
            *(u32x4*)(A2 + a2_off(t, c0)) = (u32x4){pk2(y[0], y[1]), pk2(y[2], y[3]), pk2(y[4], y[5]), pk2(y[6], y[7])};
        }
    }
}
__device__ __forceinline__ void p6_final(Frame& F) {
    const int gw = F.vcu * NWAVES + F.wave, NGW = F.G * NWAVES;
    const float* stats = (const float*)(F.ws + WS_STATS); const bf16_t* raw = (const bf16_t*)(F.ws + WS_RAW);
    const bf16_t* U = (const bf16_t*)(F.ws + WS_U); const float* rmsx = (const float*)(F.ws + WS_RMS);
    f32x4 gp[4], gi[4];
#pragma unroll
    for (int q = 0; q < 4; ++q) { gp[q] = *(const f32x4*)(F.g_post + 8 * F.lane + 512 * (q >> 1) + 4 * (q & 1)); const f32x4 g = *(const f32x4*)(F.g_pre + 8 * F.lane + 512 * (q >> 1) + 4 * (q & 1));
        gi[q] = (f32x4){1.f / g[0], 1.f / g[1], 1.f / g[2], 1.f / g[3]}; }
    for (int k = 0; k < M / NGW; ++k) {
        const int m = deal_row(k, gw, NGW);
        const f32x4 s0 = *(const f32x4*)(stats + (size_t)m * 16), s1 = *(const f32x4*)(stats + (size_t)m * 16 + 4), s2 = *(const f32x4*)(stats + (size_t)m * 16 + 8), s3 = *(const f32x4*)(stats + (size_t)m * 16 + 12);
        const float ss = ((s0[0] + s0[1]) + (s0[2] + s0[3])) + ((s1[0] + s1[1]) + (s1[2] + s1[3])) + ((s2[0] + s2[1]) + (s2[2] + s2[3])) + ((s3[0] + s3[1]) + (s3[2] + s3[3]));
        const float rstd = __builtin_amdgcn_rsqf(ss * (1.f / D) + EPS), rx = rmsx[m];
        float* orow = F.out + (size_t)m * D + 8 * F.lane; const bf16_t* rr = raw + (size_t)m * D + 8 * F.lane; const bf16_t* ur = U + (size_t)m * D + 8 * F.lane;
#pragma unroll
        for (int hf = 0; hf < 2; ++hf) {
            const u32x4 rw = __builtin_nontemporal_load((const u32x4*)(rr + 512 * hf)), uw = __builtin_nontemporal_load((const u32x4*)(ur + 512 * hf));
            const f32x4 r0 = {bflo(rw.x), bfhi(rw.x), bflo(rw.y), bfhi(rw.y)}, r1 = {bflo(rw.z), bfhi(rw.z), bflo(rw.w), bfhi(rw.w)};
            const f32x4 x0 = (f32x4){bflo(uw.x), bfhi(uw.x), bflo(uw.y), bfhi(uw.y)} * gi[2 * hf] * rx, x1 = (f32x4){bflo(uw.z), bfhi(uw.z), bflo(uw.w), bfhi(uw.w)} * gi[2 * hf + 1] * rx;
            __builtin_nontemporal_store(x0 + r0 * rstd * gp[2 * hf], (f32x4*)(orow + 512 * hf)); __builtin_nontemporal_store(x1 + r1 * rstd * gp[2 * hf + 1], (f32x4*)(orow + 512 * hf + 4));
        }
    }
}

__global__ void __launch_bounds__(NWAVES * 64, 2) fwd_kernel(Args args) {
    extern __shared__ __attribute__((aligned(16))) unsigned char lds_raw[];
    Frame F;
    F.lds = (LAS unsigned char*)lds_raw;
    F.tid = threadIdx.x; F.lane = F.tid & 63; F.wave = __builtin_amdgcn_readfirstlane(F.tid >> 6);
    F.G = gridDim.x; { const int bx = blockIdx.x; F.vcu = (F.G % 8 == 0) ? (bx % 8) * (F.G / 8) + bx / 8 : bx; }
    F.x = args.in[0]; F.meta = args.in[1]; F.g_pre = args.in[2]; F.w_in = args.in[3]; F.conv_w = args.in[4]; F.wgf = args.in[5]; F.bgf = args.in[6];
    F.wgb = args.in[7]; F.bgb = args.in[8]; F.gn = args.in[9]; F.w_oc = args.in[10]; F.w_og = args.in[11]; F.w_mo = args.in[12]; F.g_post = args.in[13];
    F.out = args.out; F.ws = args.ws;
    const int lo = args.ph_lo, hi = args.ph_hi;
#define IN(k) (lo <= (k) && (k) < hi)
    cg::grid_group grid = cg::this_grid();
    if (F.tid < 16) ((volatile LAS unsigned*)(F.lds + MISC_OFF))[F.tid] = 0u;
    __syncthreads();
    const XcdBarrier xbar = xcd_barrier_post((unsigned*)(args.ws + WS_CTL), (volatile LAS unsigned*)(F.lds + MISC_OFF));
#define SEAM(k) do { if (IN(k) && IN((k) + 1)) { if ((k) == 0 && hi > 64) grid.sync(); else xcd_barrier(xbar); } } while (0)
    unsigned char* ws = args.ws; unsigned char* dob = (unsigned char*)args.out;
    if (IN(0)) { p0_prologue(F); }
    SEAM(0);
    if (IN(1)) {
        if (blockIdx.x < META_JOBS) meta_reduce(F, (int)blockIdx.x);
        pg8::Gemm g{(const bf16_t*)(ws + WS_U), (const bf16_t*)(ws + WS_WIN), M, NSLOT, D, 0}; pg8::SlicedOrder S; S.init(M, NSLOT, F.G, (int)blockIdx.x); S.x = F.x; S.g_pre = F.g_pre; S.U = (bf16_t*)(ws + WS_U); S.rmsx = (float*)(ws + WS_RMS); S.ready = (unsigned*)(ws + WS_CTL) + 4096; S.queue = (unsigned*)(ws + WS_CTL) + 8000; S.nunits = (unsigned*)(ws + WS_CTL) + 7000; S.slot = (volatile LAS int*)(F.lds + MISC_OFF + 160);
        for (int i = F.tid; i < NWAVES * CONV_STG_WAVE / 4; i += NWAVES * 64) ((LAS unsigned*)(F.lds + CONV_STG))[i] = 0u;
        __syncthreads();
        pg8::EpiProj E{(bf16_t*)(ws + WS_SIDEP), (bf16_t*)(ws + WS_SIDEG), (bf16_t*)(ws + WS_A2), (bf16_t*)(dob + DO_Q), (bf16_t*)(dob + DO_K), (bf16_t*)(ws + WS_V), (bf16_t*)(ws + WS_SA), (bf16_t*)(ws + WS_SB), (float*)(ws + WS_LR),
                       F.conv_w, F.lds + CONV_STG + F.wave * CONV_STG_WAVE};
        pg8::gemm_phase<pg8::EpiProj, pg8::SlicedOrder>(F.lds, g, S, E);
    }
    SEAM(1);
    if (IN(2)) {
        conv_fixup(F);
        gla::Tensors X{(const bf16_t*)(dob + DO_Q), (const bf16_t*)(dob + DO_K), (const bf16_t*)(ws + WS_V), (const float*)(ws + WS_LR),
                       (const bf16_t*)(ws + WS_META + META_K), (const bf16_t*)(ws + WS_META + META_V), (const float*)(ws + WS_META + META_LR),
                       F.wgf, F.bgf, F.wgb, F.bgb, (bf16_t*)(dob + DO_OF), (bf16_t*)(ws + WS_OB), (bf16_t*)(ws + WS_A2), F.gn};
        { const int u = (int)blockIdx.x;
          const unsigned* nu = (const unsigned*)(ws + WS_CTL) + 7000; const unsigned mine = nu[u], other = nu[u ^ 1];
          const int dir = (IN(1) && mine != other) ? (mine > other ? 0 : 1) : (u & 1);
          gla::unit(F.lds, X, u >> 3, (u >> 1) & 3, dir, xbar); }
    }
    SEAM(2);
    if (IN(4)) {
        pg8::Gemm g{(const bf16_t*)(ws + WS_A2), (const bf16_t*)(ws + WS_WMG), M, D, 2 * D, 1}; pg8::StaticOrder S; S.init(M, D, F.G, (int)blockIdx.x);
        pg8::EpiMerge E{(const bf16_t*)(ws + WS_SA), (const bf16_t*)(ws + WS_SB), (bf16_t*)(ws + WS_MERGED)};
        pg8::gemm_phase<pg8::EpiMerge, pg8::StaticOrder>(F.lds, g, S, E);
    }
    SEAM(4);
    if (IN(5)) {
        pg8::Gemm g{(const bf16_t*)(ws + WS_MERGED), (const bf16_t*)(ws + WS_WOUT), M, D, D, 1}; pg8::StaticOrder S; S.init(M, D, F.G, (int)blockIdx.x); S.rev = 1;
        pg8::EpiOut E{(bf16_t*)(ws + WS_RAW), (float*)(ws + WS_STATS)};
        pg8::gemm_phase<pg8::EpiOut, pg8::StaticOrder>(F.lds, g, S, E);
    }
    SEAM(5);
    if (IN(6)) { p6_final(F); }
#undef IN
#undef SEAM
}

extern "C" void kernel_launch(void* const* d_in, const int* in_sizes, int n_in, void* d_out, int out_size, void* d_ws, size_t ws_size, hipStream_t stream) {
    static int grid = 0;
    if (grid == 0) {
        if (n_in != 14 || in_sizes[0] != M * D || out_size != M * D || ws_size < WS_END) {
            fprintf(stderr, "kernel_launch: unexpected shapes (n_in %d, in0 %d, out %d, ws %zu; need ws >= %zu); nothing launched\n", n_in, n_in > 0 ? in_sizes[0] : -1, out_size, ws_size, (size_t)WS_END); grid = -1; return; }
        int dev = 0, cus = 0, per_cu = 0;
        if (hipGetDevice(&dev) != hipSuccess || hipDeviceGetAttribute(&cus, hipDeviceAttributeMultiprocessorCount, dev) != hipSuccess) { grid = -1; return; }
        if (hipFuncSetAttribute((const void*)fwd_kernel, hipFuncAttributeMaxDynamicSharedMemorySize, LDS_BYTES) != hipSuccess) { fprintf(stderr, "kernel_launch: hipFuncSetAttribute failed\n"); grid = -1; return; }
        if (hipOccupancyMaxActiveBlocksPerMultiprocessor(&per_cu, (const void*)fwd_kernel, NWAVES * 64, LDS_BYTES) != hipSuccess || per_cu < 1) { fprintf(stderr, "kernel_launch: occupancy query says %d blocks per CU\n", per_cu); per_cu = 1; }
        (void)hipGetLastError();
        grid = cus;
        if (grid != NB * NH * 2) { fprintf(stderr, "kernel_launch: this kernel needs exactly %d workgroups (one GLA unit each); the device has %d CUs; nothing launched\n", NB * NH * 2, cus); grid = -1; return; }
    }
    if (grid < 0) return;
    Args a{};
    for (int i = 0; i < 14; ++i) a.in[i] = (const float*)d_in[i];
    a.out = (float*)d_out; a.ws = (unsigned char*)d_ws;
    if (hipMemsetAsync((char*)d_ws + WS_CTL, 0, CTL_BYTES, stream) != hipSuccess) { fprintf(stderr, "kernel_launch: memset of the barrier words failed\n"); return; }
    a.ph_lo = 0; a.ph_hi = 7;
    void* params[] = {&a};
    hipError_t e = hipLaunchCooperativeKernel((const void*)fwd_kernel, dim3(grid), dim3(NWAVES * 64), params, LDS_BYTES, stream);
    if (e != hipSuccess) fprintf(stderr, "kernel_launch: cooperative launch failed: %s (grid %d)\n", hipGetErrorString(e), grid);
}
```
